# Optimizing an MI355X kernel written in HIP

```python
import math
import numpy as np
import jax
import jax.numpy as jnp
from jax import lax

D_MODEL = 1024
BATCH = 8
SEQ = 4096
DEPTH = 4

GRID_W = 64
CTX_LEN = 256
N_MIXERS = 3
N_NA_LAYERS = (DEPTH + 2) // 3
N_HY_LAYERS = (DEPTH + 1) // 3
N_GM_LAYERS = DEPTH // 3

NA_HEADS = 16
NA_HEAD_DIM = D_MODEL // NA_HEADS
WIN_H = 8
WIN_W = 16
NA_QBLK = 16
NA_BAND = 32

HY_EMB = 33
HY_ORDER = 64
HY_SHORT = 3
HY_FAST_DECAY = 0.3
HY_SLOW_DECAY = 1.5
HY_DECAY_TARGET = 1e-2

GM_CHUNK = 128
GM_WIDTH = 3 * D_MODEL
GM_GROUPS = 16

N_EXPERTS = 32
TOP_K = 4
D_FF = D_MODEL
SWIGLU_ALPHA = 1.702
SWIGLU_LIMIT = 7.0
MOE_BLOCK = 128

EPS = 1e-6
NEG_INF = -1e30

kernel_name = 'hybrid_natten_hyena_gmlp_moe_dit'


def rms_norm(x, g):
    xf = x.astype(jnp.float32)
    y = xf * lax.rsqrt(jnp.mean(xf * xf, axis=-1, keepdims=True) + EPS)
    return (y * g.astype(jnp.float32)).astype(x.dtype)


def layer_norm(x, g, b):
    xf = x.astype(jnp.float32)
    mu = jnp.mean(xf, axis=-1, keepdims=True)
    var = jnp.mean(jnp.square(xf - mu), axis=-1, keepdims=True)
    y = (xf - mu) * lax.rsqrt(var + EPS) * g.astype(jnp.float32) + b.astype(jnp.float32)
    return y.astype(x.dtype)


def modulate(h, shift, scale):
    return h * (1 + scale) + shift


def _na_column_tables():
    n_blk = GRID_W // NA_QBLK
    q_cols = np.arange(GRID_W).reshape(n_blk, NA_QBLK)
    win_start = np.clip(q_cols - WIN_W // 2, 0, GRID_W - WIN_W)
    band_start = np.clip(np.arange(n_blk) * NA_QBLK - WIN_W // 2, 0, GRID_W - NA_BAND)
    band_cols = band_start[:, None] + np.arange(NA_BAND)
    kc = band_cols[:, None, :]
    valid = (kc >= win_start[:, :, None]) & (kc < win_start[:, :, None] + WIN_W)
    dcol = np.clip(kc - q_cols[:, :, None] + WIN_W - 1, 0, 2 * WIN_W - 2)
    return band_cols, valid, dcol


def neighbourhood_attention(hx, hc, w_qkv, rpb, w_o, need_ctx):
    B, L, D = hx.shape
    H, Dh = NA_HEADS, NA_HEAD_DIM
    rows = L // GRID_W
    kh = min(WIN_H, rows)
    n_blk = GRID_W // NA_QBLK
    scale = Dh ** -0.5
    band_cols, col_valid, dcol = _na_column_tables()
    col_valid = jnp.asarray(col_valid)[:, :, None, :]

    q, k, v = jnp.split(hx @ w_qkv, 3, axis=-1)
    q = q.reshape(B, rows, GRID_W, H, Dh)
    k = k.reshape(B, rows, GRID_W, H, Dh)
    v = v.reshape(B, rows, GRID_W, H, Dh)
    if need_ctx:
        qc, kc, vc = jnp.split(hc @ w_qkv, 3, axis=-1)
        qc = qc.reshape(B, -1, H, Dh)
    else:
        kc, vc = jnp.split(hc @ w_qkv[:, D:], 2, axis=-1)
    kc = kc.reshape(B, -1, H, Dh)
    vc = vc.reshape(B, -1, H, Dh)
    n_loc = kh * NA_BAND

    def row_block(r):
        r0 = jnp.clip(r - kh // 2, 0, rows - kh)
        k_band = lax.dynamic_slice_in_dim(k, r0, kh, axis=1)[:, :, band_cols]
        v_band = lax.dynamic_slice_in_dim(v, r0, kh, axis=1)[:, :, band_cols]
        q_row = lax.dynamic_index_in_dim(q, r, axis=1, keepdims=False).reshape(B, n_blk, NA_QBLK, H, Dh)
        s_loc = jnp.einsum('bjqhd,bkjchd->bhjqkc', q_row, k_band,
                           preferred_element_type=jnp.float32) * scale
        drow = r0 + jnp.arange(kh) - r + WIN_H - 1
        bias = rpb[:, drow][:, :, dcol].transpose(0, 2, 3, 1, 4)
        s_loc = jnp.where(col_valid, s_loc + bias.astype(jnp.float32), NEG_INF)
        s_ctx = jnp.einsum('bjqhd,bmhd->bhjqm', q_row, kc,
                           preferred_element_type=jnp.float32) * scale
        s_all = jnp.concatenate([s_loc.reshape(B, H, n_blk, NA_QBLK, n_loc), s_ctx], axis=-1)
        p = jax.nn.softmax(s_all, axis=-1).astype(v.dtype)
        p_loc = p[..., :n_loc].reshape(B, H, n_blk, NA_QBLK, kh, NA_BAND)
        p_ctx = p[..., n_loc:]
        o = (jnp.einsum('bhjqkc,bkjchd->bjqhd', p_loc, v_band)
             + jnp.einsum('bhjqm,bmhd->bjqhd', p_ctx, vc))
        return o.reshape(B, GRID_W, D)

    o = lax.map(row_block, jnp.arange(rows))
    y = o.transpose(1, 0, 2, 3).reshape(B, L, D) @ w_o
    if not need_ctx:
        return y, None
    s = jnp.einsum('bqhd,bkhd->bhqk', qc, kc, preferred_element_type=jnp.float32) * scale
    p = jax.nn.softmax(s, axis=-1).astype(vc.dtype)
    yc = jnp.einsum('bhqk,bkhd->bqhd', p, vc).reshape(B, -1, D) @ w_o
    return y, yc


def short_conv(u, w, b):
    y = lax.conv_general_dilated(u, w[:, None, :].astype(u.dtype), window_strides=(1,),
                                 padding=((HY_SHORT // 2, HY_SHORT // 2),),
                                 dimension_numbers=('NWC', 'WIO', 'NWC'),
                                 feature_group_count=u.shape[-1])
    return y + b


def hyena_filter(L, f_w1, f_b1, f_w2, f_b2, f_w3, f_b3, f_freq, f_wout):
    f32 = jnp.float32
    t = jnp.linspace(0.0, 1.0, L, dtype=f32)[:, None]
    bands = (HY_EMB - 1) // 2
    w = 2 * math.pi * jnp.arange(L, dtype=f32)[:, None] / L
    f = jnp.linspace(1e-4, bands - 1, bands, dtype=f32)[None, :]
    z = jnp.concatenate([t, jnp.cos(f * w), -jnp.sin(f * w)], axis=-1)
    freq = f_freq.astype(f32)
    a = jnp.sin(freq * (z @ f_w1.astype(f32) + f_b1.astype(f32)))
    a = jnp.sin(freq * (a @ f_w2.astype(f32) + f_b2.astype(f32)))
    a = jnp.sin(freq * (a @ f_w3.astype(f32) + f_b3.astype(f32)))
    h = a @ f_wout.astype(f32)
    deltas = jnp.linspace(math.log(HY_FAST_DECAY) / HY_DECAY_TARGET,
                          math.log(HY_SLOW_DECAY) / HY_DECAY_TARGET, D_MODEL, dtype=f32)
    h = h * jnp.exp(-t * jnp.abs(jnp.concatenate([deltas, deltas])))
    h_fwd, h_bwd = h[:, :D_MODEL], h[:, D_MODEL:]
    k = jnp.concatenate([h_fwd[:1] + h_bwd[:1], h_fwd[1:], jnp.zeros((1, D_MODEL), f32),
                         h_bwd[:0:-1]], axis=0)
    return k / jnp.sum(jnp.abs(k), axis=0, keepdims=True)


def long_conv(v, k, skip):
    L = v.shape[1]
    vf = jnp.fft.rfft(v.astype(jnp.float32), n=2 * L, axis=1)
    kf = jnp.fft.rfft(k, axis=0)
    y = jnp.fft.irfft(vf * kf[None], n=2 * L, axis=1)[:, :L]
    return (y + v.astype(jnp.float32) * skip.astype(jnp.float32)).astype(v.dtype)


def hyena_mixer(h, w_in, b_in, conv_w, conv_b, f_w1, f_b1, f_w2, f_b2, f_w3, f_b3, f_freq,
                f_wout, skip, w_out, b_out):
    L = h.shape[1]
    u = short_conv(h @ w_in + b_in, conv_w, conv_b)
    x0, x1, v = jnp.split(u, 3, axis=-1)
    k = hyena_filter(L, f_w1, f_b1, f_w2, f_b2, f_w3, f_b3, f_freq, f_wout)
    y = long_conv(v * x1, k, skip) * x0
    return y @ w_out + b_out


def chunk_gmlp(h, w_in, b_in, ln_g, ln_b, w_s, b_s, w_out, b_out):
    B, L, _ = h.shape
    z = jax.nn.gelu(h @ w_in + b_in, approximate=False)
    u, v = jnp.split(z, 2, axis=-1)
    v = layer_norm(v, ln_g, ln_b).reshape(B, L // GM_CHUNK, GM_CHUNK, GM_GROUPS, GM_WIDTH // GM_GROUPS)
    v = jnp.einsum('gpq,bnqgc->bnpgc', w_s, v) + b_s.T[None, None, :, :, None]
    return (u * v.reshape(B, L, GM_WIDTH)) @ w_out + b_out


def moe_ffn(h, router_w, router_b, w_gu, b_gu, w_dn, b_dn):
    T, D = h.shape
    n_assign = T * TOP_K
    logits = jnp.dot(h, router_w, preferred_element_type=jnp.float32) + router_b.astype(jnp.float32)
    top_logit, top_e = lax.top_k(logits, TOP_K)
    gate = jax.nn.softmax(top_logit, axis=-1).reshape(-1)
    flat_e = top_e.reshape(-1)
    flat_tok = jnp.arange(n_assign, dtype=jnp.int32) // TOP_K
    order = jnp.argsort(flat_e)
    e_sorted, tok_sorted, gate_sorted = flat_e[order], flat_tok[order], gate[order]
    counts = jnp.bincount(flat_e, length=N_EXPERTS)
    padded = (counts + MOE_BLOCK - 1) // MOE_BLOCK * MOE_BLOCK
    pad_end = jnp.cumsum(padded)
    pad_start = pad_end - padded
    grp_start = jnp.cumsum(counts) - counts
    dest = pad_start[e_sorted] + jnp.arange(n_assign, dtype=jnp.int32) - grp_start[e_sorted]
    n_blocks = -(-n_assign // MOE_BLOCK) + N_EXPERTS
    buf = jnp.zeros((n_blocks * MOE_BLOCK, D), h.dtype).at[dest].set(h[tok_sorted])
    blk_e = jnp.minimum(jnp.searchsorted(pad_end, jnp.arange(n_blocks, dtype=jnp.int32) * MOE_BLOCK,
                                         side='right'), N_EXPERTS - 1)

    def expert_block(args):
        xb, e = args
        gu = xb @ w_gu[e] + b_gu[e]
        x_glu = jnp.minimum(gu[:, :D_FF], SWIGLU_LIMIT)
        x_lin = jnp.clip(gu[:, D_FF:], -SWIGLU_LIMIT, SWIGLU_LIMIT)
        act = x_glu * jax.nn.sigmoid(SWIGLU_ALPHA * x_glu) * (x_lin + 1)
        return act @ w_dn[e] + b_dn[e]

    out = lax.map(expert_block, (buf.reshape(n_blocks, MOE_BLOCK, D), blk_e)).reshape(-1, D)
    y = out[dest].astype(jnp.float32) * gate_sorted[:, None]
    return jax.ops.segment_sum(y, tok_sorted, num_segments=T).astype(h.dtype)


def setup_inputs(seed: int = 0) -> dict:
    key = jax.random.key(seed)
    keys = iter(jax.random.split(key, 48))
    D = D_MODEL

    def nrm(shape, scale):
        return jax.random.normal(next(keys), shape, jnp.float32) * scale

    def gain(shape):
        return 1.0 + nrm(shape, 0.1)

    return {
        'x': nrm((BATCH, SEQ, D), 1.0),
        'c': nrm((BATCH, D), 1.0),
        'ctx': nrm((BATCH, CTX_LEN, D), 1.0),
        'c_ctx': nrm((D,), 1.0),
        'ada_w': nrm((DEPTH, D, 6 * D), 0.5 * D ** -0.5),
        'ada_b': nrm((DEPTH, 6 * D), 0.01),
        'norm1_g': gain((DEPTH, D)),
        'norm2_g': gain((DEPTH, D)),
        'final_g': gain((D,)),
        'na_w_qkv': nrm((N_NA_LAYERS, D, 3 * D), D ** -0.5),
        'na_rpb': nrm((N_NA_LAYERS, NA_HEADS, 2 * WIN_H - 1, 2 * WIN_W - 1), 0.2),
        'na_w_o': nrm((N_NA_LAYERS, D, D), D ** -0.5),
        'hy_w_in': nrm((N_HY_LAYERS, D, 3 * D), D ** -0.5),
        'hy_b_in': nrm((N_HY_LAYERS, 3 * D), 0.01),
        'hy_conv_w': nrm((N_HY_LAYERS, HY_SHORT, 3 * D), HY_SHORT ** -0.5),
        'hy_conv_b': nrm((N_HY_LAYERS, 3 * D), 0.01),
        'hy_f_w1': nrm((N_HY_LAYERS, HY_EMB, HY_ORDER), HY_EMB ** -0.5),
        'hy_f_b1': nrm((N_HY_LAYERS, HY_ORDER), 0.1),
        'hy_f_w2': nrm((N_HY_LAYERS, HY_ORDER, HY_ORDER), HY_ORDER ** -0.5),
        'hy_f_b2': nrm((N_HY_LAYERS, HY_ORDER), 0.1),
        'hy_f_w3': nrm((N_HY_LAYERS, HY_ORDER, HY_ORDER), HY_ORDER ** -0.5),
        'hy_f_b3': nrm((N_HY_LAYERS, HY_ORDER), 0.1),
        'hy_f_freq': gain((N_HY_LAYERS, HY_ORDER)),
        'hy_f_wout': nrm((N_HY_LAYERS, HY_ORDER, 2 * D), HY_ORDER ** -0.5),
        'hy_skip': nrm((N_HY_LAYERS, D), 1.0),
        'hy_w_out': nrm((N_HY_LAYERS, D, D), D ** -0.5),
        'hy_b_out': nrm((N_HY_LAYERS, D), 0.01),
        'gm_w_in': nrm((N_GM_LAYERS, D, 2 * GM_WIDTH), D ** -0.5),
        'gm_b_in': nrm((N_GM_LAYERS, 2 * GM_WIDTH), 0.01),
        'gm_ln_g': gain((N_GM_LAYERS, GM_WIDTH)),
        'gm_ln_b': nrm((N_GM_LAYERS, GM_WIDTH), 0.01),
        'gm_w_s': nrm((N_GM_LAYERS, GM_GROUPS, GM_CHUNK, GM_CHUNK), GM_CHUNK ** -0.5),
        'gm_b_s': gain((N_GM_LAYERS, GM_GROUPS, GM_CHUNK)),
        'gm_w_out': nrm((N_GM_LAYERS, GM_WIDTH, D), GM_WIDTH ** -0.5),
        'gm_b_out': nrm((N_GM_LAYERS, D), 0.01),
        'moe_router_w': nrm((DEPTH, D, N_EXPERTS), D ** -0.5),
        'moe_router_b': nrm((DEPTH, N_EXPERTS), 0.01),
        'moe_w_gu': nrm((DEPTH, N_EXPERTS, D, 2 * D_FF), D ** -0.5),
        'moe_b_gu': nrm((DEPTH, N_EXPERTS, 2 * D_FF), 0.01),
        'moe_w_dn': nrm((DEPTH, N_EXPERTS, D_FF, D), D_FF ** -0.5),
        'moe_b_dn': nrm((DEPTH, N_EXPERTS, D), 0.01),
    }


def reference(x, c, ctx, c_ctx, ada_w, ada_b, norm1_g, norm2_g, final_g,
              na_w_qkv, na_rpb, na_w_o,
              hy_w_in, hy_b_in, hy_conv_w, hy_conv_b, hy_f_w1, hy_f_b1, hy_f_w2, hy_f_b2,
              hy_f_w3, hy_f_b3, hy_f_freq, hy_f_wout, hy_skip, hy_w_out, hy_b_out,
              gm_w_in, gm_b_in, gm_ln_g, gm_ln_b, gm_w_s, gm_b_s, gm_w_out, gm_b_out,
              moe_router_w, moe_router_b, moe_w_gu, moe_b_gu, moe_w_dn, moe_b_dn):
    B, L, D = x.shape
    n_ctx = ctx.shape[1]
    silu_c = jax.nn.silu(c)
    silu_cc = jax.nn.silu(c_ctx)[None]
    cx = ctx
    for i in range(DEPTH):
        kind, j = i % N_MIXERS, i // N_MIXERS
        ctx_out = i < DEPTH - 1
        mod_x = (silu_c @ ada_w[i] + ada_b[i])[:, None, :]
        mod_c = (silu_cc @ ada_w[i] + ada_b[i])[:, None, :]
        sh1, sc1, g1, sh2, sc2, g2 = jnp.split(mod_x, 6, axis=-1)
        csh1, csc1, cg1, csh2, csc2, cg2 = jnp.split(mod_c, 6, axis=-1)

        hx = modulate(rms_norm(x, norm1_g[i]), sh1, sc1)
        hc = modulate(rms_norm(cx, norm1_g[i]), csh1, csc1) if (ctx_out or kind == 0) else None
        if kind == 0:
            yx, yc = neighbourhood_attention(hx, hc, na_w_qkv[j], na_rpb[j], na_w_o[j], ctx_out)
        elif kind == 1:
            hy = (hy_w_in[j], hy_b_in[j], hy_conv_w[j], hy_conv_b[j], hy_f_w1[j], hy_f_b1[j],
                  hy_f_w2[j], hy_f_b2[j], hy_f_w3[j], hy_f_b3[j], hy_f_freq[j], hy_f_wout[j],
                  hy_skip[j], hy_w_out[j], hy_b_out[j])
            yx = hyena_mixer(hx, *hy)
            yc = hyena_mixer(hc, *hy) if ctx_out else None
        else:
            gm = (gm_w_in[j], gm_b_in[j], gm_ln_g[j], gm_ln_b[j], gm_w_s[j], gm_b_s[j],
                  gm_w_out[j], gm_b_out[j])
            yx = chunk_gmlp(hx, *gm)
            yc = chunk_gmlp(hc, *gm) if ctx_out else None
        x = x + g1 * yx

        moe_p = (moe_router_w[i], moe_router_b[i], moe_w_gu[i], moe_b_gu[i], moe_w_dn[i], moe_b_dn[i])
        hx2 = modulate(rms_norm(x, norm2_g[i]), sh2, sc2).reshape(B * L, D)
        if ctx_out:
            cx = cx + cg1 * yc
            hc2 = modulate(rms_norm(cx, norm2_g[i]), csh2, csc2).reshape(B * n_ctx, D)
            y = moe_ffn(jnp.concatenate([hx2, hc2], axis=0), *moe_p)
            x = x + g2 * y[:B * L].reshape(B, L, D)
            cx = cx + cg2 * y[B * L:].reshape(B, n_ctx, D)
        else:
            x = x + g2 * moe_ffn(hx2, *moe_p).reshape(B, L, D)
    return rms_norm(x, final_g)
```

```cpp
#include <hip/hip_runtime.h>
#include <stdint.h>
#include <math.h>

#ifndef GEMM_SP2
#define GEMM_SP2 1
#endif
#ifndef MK_SINGLE
#define MK_SINGLE 1
#endif

#ifndef REP_ATTN
#define REP_ATTN 1
#endif
#ifndef REP_P0
#define REP_P0 1
#endif
#ifndef REP_MOE
#define REP_MOE 1
#endif
#ifndef REP_DENSE
#define REP_DENSE 1
#endif
#ifndef REP_MIX
#define REP_MIX 1
#endif
#ifndef REP_QKV
#define REP_QKV 1
#endif
#ifndef REP_GMIN
#define REP_GMIN 1
#endif
#ifndef REP_BAR
#define REP_BAR 0
#endif
#ifndef REP_OUT
#define REP_OUT 1
#endif
#ifndef REP_DRY
#define REP_DRY 0
#endif
#ifndef REP_N2
#define REP_N2 1
#endif
#ifndef REP_COMB
#define REP_COMB 1
#endif
#ifndef REP_P1A
#define REP_P1A 1
#endif
#ifndef REP_P1B
#define REP_P1B 1
#endif
#ifndef ATTN_PROBE
#define ATTN_PROBE 0
#endif
#ifndef REP_MIXA
#define REP_MIXA 1
#endif
#ifndef REP_MIXB
#define REP_MIXB 1
#endif
#ifndef REP_MIXC
#define REP_MIXC 1
#endif
#ifndef REP_MIX2
#define REP_MIX2 1
#endif
#define DEVFN __device__ __forceinline__
typedef unsigned short bf16_t;
typedef short bf16x8 __attribute__((ext_vector_type(8)));
typedef float f32x4 __attribute__((ext_vector_type(4)));
typedef float f32x2 __attribute__((ext_vector_type(2)));
typedef unsigned u32x4 __attribute__((ext_vector_type(4)));
typedef unsigned u32x2 __attribute__((ext_vector_type(2)));

constexpr int DM = 1024, NB = 8, SEQ = 4096, CTXL = 256, TL = NB * SEQ, TC = NB * CTXL, TT = TL + TC;
constexpr int NEXP = 32, MOE_ROWS = 4 * TT + NEXP * 256;
constexpr int SMEM_GEMM = 131072, SMEM_MISC = 12288, SMEM_BYTES = 158 * 1024;
constexpr int NTHREADS = 512;

#define XB_TMO      128
#define XB_XCNT(j)  (256  + 64 * (j))
#define XB_XSUB(j)  (1280 + 64 * (j))
#define XB_XGEN(j)  (2304 + 64 * (j))
#define XB_TOP      3328
#define XB_TOPGEN   3392
#define XCD_BAR_WORDS 3456
#define XB_SPIN_CAP (1u << 18)
#define LAS __attribute__((address_space(3)))

__device__ __forceinline__ unsigned xb_ld(unsigned* p)              { return __hip_atomic_load(p, __ATOMIC_RELAXED, __HIP_MEMORY_SCOPE_AGENT); }
__device__ __forceinline__ unsigned xb_add(unsigned* p, unsigned v) { return __hip_atomic_fetch_add(p, v, __ATOMIC_RELAXED, __HIP_MEMORY_SCOPE_AGENT); }
__device__ __forceinline__ unsigned xb_xcc_id() { return (unsigned)__builtin_amdgcn_s_getreg((3 << 11) | 20) & 0xFu; }
#define XB_SPIN(cond, bar) do { unsigned _sp = 0; while (cond) { __builtin_amdgcn_s_sleep(1); \
    if ((++_sp & 255u) == 0u) { if (xb_ld(&(bar)[XB_TMO])) break; if (_sp > XB_SPIN_CAP) { atomicAdd(&(bar)[XB_TMO], 1u); break; } } } } while (0)

struct XcdBarrier { unsigned* bar; unsigned x; volatile LAS unsigned* st; };

__device__ __forceinline__ XcdBarrier xcd_barrier_post(unsigned* bar, volatile LAS unsigned* st) {
    XcdBarrier b; b.bar = bar; b.x = xb_xcc_id(); b.st = st;
    if (threadIdx.x == 0) (void)xb_add(&bar[XB_XCNT(b.x)], 1u);
    return b;
}
__device__ __forceinline__ void xcd_barrier_complete(unsigned* bar, unsigned x, unsigned& nloc, unsigned& nx) {
    const unsigned G = gridDim.x * gridDim.y * gridDim.z;
    unsigned sum, cnt, mine, sp = 0u;
    for (;;) {
        sum = 0u; cnt = 0u; mine = 0u;
#pragma unroll
        for (unsigned j = 0; j < 16; ++j) { const unsigned c = xb_ld(&bar[XB_XCNT(j)]); sum += c; cnt += (c > 0u) ? 1u : 0u; mine = (j == x) ? c : mine; }
        if (sum == G) break;
        __builtin_amdgcn_s_sleep(1);
        if ((++sp & 255u) == 0u) { if (xb_ld(&bar[XB_TMO])) break; if (sp > XB_SPIN_CAP) { atomicAdd(&bar[XB_TMO], 1u); break; } }
    }
    nloc = mine > 0u ? mine : 1u; nx = cnt > 0u ? cnt : 1u;
}
__device__ __forceinline__ void xcd_barrier(const XcdBarrier& b) {
    asm volatile("s_waitcnt vmcnt(0)" ::: "memory");
    __syncthreads();
    if (threadIdx.x == 0) {
        unsigned* bar = b.bar;
        __builtin_amdgcn_s_waitcnt(0);
        unsigned nloc = b.st[0], nx = b.st[1];
        if (nloc == 0u) { xcd_barrier_complete(bar, b.x, nloc, nx); b.st[0] = nloc; b.st[1] = nx; }
        const unsigned old = xb_add(&bar[XB_XSUB(b.x)], 1u);
        const unsigned gen = old / nloc;
        if (old + 1u == (gen + 1u) * nloc) {
            __builtin_amdgcn_fence(__ATOMIC_RELEASE, "agent");
            asm volatile("s_waitcnt vmcnt(0)" ::: "memory");
            const unsigned og = xb_add(&bar[XB_TOP], 1u);
            const unsigned tg = og / nx;
            if (og + 1u == (tg + 1u) * nx) xb_add(&bar[XB_TOPGEN], 1u);
            else XB_SPIN(xb_ld(&bar[XB_TOPGEN]) == tg, bar);
            __builtin_amdgcn_fence(__ATOMIC_ACQUIRE, "agent");
            xb_add(&bar[XB_XGEN(b.x)], 1u);
            asm volatile("s_waitcnt vmcnt(0)" ::: "memory");
        } else {
            XB_SPIN(xb_ld(&bar[XB_XGEN(b.x)]) == gen, bar);
            __builtin_amdgcn_fence(__ATOMIC_ACQUIRE, "agent");
            asm volatile("s_waitcnt vmcnt(0)" ::: "memory");
        }
    }
    __syncthreads();
}

struct Params {
    const float *x, *c, *ctx, *c_ctx, *ada_w, *ada_b, *norm1_g, *norm2_g, *final_g;
    const float *na_w_qkv, *na_rpb, *na_w_o;
    const float *hy_w_in, *hy_b_in, *hy_conv_w, *hy_conv_b, *hy_f_w1, *hy_f_b1, *hy_f_w2, *hy_f_b2, *hy_f_w3, *hy_f_b3, *hy_f_freq, *hy_f_wout, *hy_skip, *hy_w_out, *hy_b_out;
    const float *gm_w_in, *gm_b_in, *gm_ln_g, *gm_ln_b, *gm_w_s, *gm_b_s, *gm_w_out, *gm_b_out;
    const float *moe_router_w, *moe_router_b, *moe_w_gu, *moe_b_gu, *moe_w_dn, *moe_b_dn;
    float* out;
    unsigned* bar;
    int* cnt;
    bf16_t* X;
    bf16_t* HX;
    float* MOD;
    bf16_t *WQKV, *WO, *HYIN, *HYOUT, *GMIN, *GMOUT, *GMWS, *MOEGU, *MOEDN;
    float* FA;
    bf16_t* RK4;
    float* KC;
    int* toklist;
    float* gatelist;
    int* assign;
    bf16_t* ACT;
    bf16_t* OUTS;
    float* STAT;
    float* GMS0;
    unsigned char* BIG;
    int seg_lo, seg_hi;
};

constexpr size_t SZ_TD = (size_t)TT * DM * 2;
constexpr size_t NA_Q = 0, NA_K = SZ_TD, NA_VTL = 2 * SZ_TD, NA_VTC = NA_VTL + (size_t)TL * DM * 2, NA_O = NA_VTC + (size_t)TC * DM * 2, NA_END = NA_O + SZ_TD;
constexpr size_t HY_U = 0, HY_X0 = 3 * SZ_TD, HY_VXTL = HY_X0 + SZ_TD, HY_VXTC = HY_VXTL + (size_t)TL * DM * 2, HY_YTL = HY_VXTC + (size_t)TC * DM * 2,
                 HY_YTC = HY_YTL + (size_t)TL * DM * 2, HY_YB = HY_YTC + (size_t)TC * DM * 2, HY_END = HY_YB + SZ_TD;
constexpr size_t GM_Z = 0, GM_VT = 6 * SZ_TD, GM_UV = 9 * SZ_TD, GM_END = 12 * SZ_TD;
constexpr size_t BIG_BYTES = GM_END;

DEVFN int tidx() { int t = threadIdx.x; asm volatile("" : "+v"(t)); return t; }
#define TIDX tidx()
typedef __bf16 bf16x2_t __attribute__((ext_vector_type(2)));
DEVFN unsigned pk2(float lo, float hi) { f32x2 v = {lo, hi}; bf16x2_t r = __builtin_convertvector(v, bf16x2_t); return __builtin_bit_cast(unsigned, r); }
DEVFN float bflo(unsigned u) { return __uint_as_float(u << 16); }
DEVFN float bfhi(unsigned u) { return __uint_as_float(u & 0xffff0000u); }
DEVFN float bf2f(bf16_t b) { return __uint_as_float((unsigned)b << 16); }
DEVFN float wave_sum(float v) {
#pragma unroll
    for (int o = 1; o < 64; o <<= 1) v += __shfl_xor(v, o);
    return v;
}
DEVFN f32x2 gelu_pk(f32x2 v) {
    f32x2 a = __builtin_elementwise_abs(v); a.x = fminf(a.x, 6.0f); a.y = fminf(a.y, 6.0f);
    f32x2 q = a * (-3.115766594419256e-05f) + 0.000740654009860009f; q = q * a + (-0.00794870126992464f); q = q * a + 0.05315221846103668f; q = q * a + 0.4589992165565491f; q = q * a + 1.1511220932006836f; q = q * a + 1.0f;
    f32x2 t; t.x = __builtin_amdgcn_exp2f(-q.x); t.y = __builtin_amdgcn_exp2f(-q.y);
    const f32x2 m = v * t, r = v - m;
    f32x2 o; o.x = v.x < 0.f ? m.x : r.x; o.y = v.y < 0.f ? m.y : r.y; return o;
}

constexpr int BM = 256, BK = 64, HALF = 128, HTB = HALF * BK * 2;
DEVFN int lds_byte(int r, int c) { int st = (r >> 4) * 2 + (c >> 5), rr = r & 15, cc = c & 31, ob = rr * 64 + cc * 2; return st * 1024 + (ob ^ (((ob >> 9) & 1) << 5)); }
DEVFN void stage_rc(int b, int& R, int& C) { int st = b / 1024, sb = b % 1024, swz = sb ^ (((sb >> 9) & 1) << 5); R = (st >> 1) * 16 + swz / 64; C = (st & 1) * 32 + (swz % 64) / 2; }

template <bool TRANS, class EPI>
DEVFN void gemm_tile(char* smem, const char* A0, const char* A1, const unsigned (&va)[2][2], const char* B0p, const char* B1p, const unsigned (&vb)[2], int nt, const EPI& epi) {
    LAS unsigned char* lds = (LAS unsigned char*)smem;
    const int tid = TIDX, wid = __builtin_amdgcn_readfirstlane(tid >> 6), lane = tid & 63, wr = wid >> 2, wc = wid & 3, fr = lane & 15, fq = lane >> 4;
    const unsigned ldsw = (unsigned)wid * 1024u;
    const int aoff = lds_byte(wr * 64 + fr, fq * 8), boff = lds_byte(wc * 32 + fr, fq * 8);
#define SA(b,h) (((b)*2+(h))*HTB)
#define SB(b,h) ((4+(b)*2+(h))*HTB)
#define STAGE(bufoff,gbase,voff) do{ _Pragma("unroll") for(int _i=0;_i<2;++_i) \
      __builtin_amdgcn_global_load_lds((const unsigned*)((const char*)(gbase)+(voff)[_i]), (LAS unsigned*)(lds+(bufoff)+ldsw+_i*8192),16,0,0);}while(0)
#define LDA(dst,b,h) do{ _Pragma("unroll") for(int m=0;m<4;++m) _Pragma("unroll") for(int k=0;k<2;++k) dst[m][k]=*(const LAS bf16x8*)(lds+SA(b,h)+aoff+m*2048+k*1024);}while(0)
#define LDB(dst,b,h) do{ _Pragma("unroll") for(int n=0;n<2;++n) _Pragma("unroll") for(int k=0;k<2;++k) dst[n][k]=*(const LAS bf16x8*)(lds+SB(b,h)+boff+n*2048+k*1024);}while(0)
#define MMA(ai,bj,At_,Bt_) do{__builtin_amdgcn_s_setprio(1); \
    _Pragma("unroll") for(int m=0;m<4;++m) _Pragma("unroll") for(int n=0;n<2;++n) _Pragma("unroll") for(int k=0;k<2;++k) \
      acc[ai][bj][m][n]= TRANS ? __builtin_amdgcn_mfma_f32_16x16x32_bf16(Bt_[n][k],At_[m][k],acc[ai][bj][m][n],0,0,0) \
                               : __builtin_amdgcn_mfma_f32_16x16x32_bf16(At_[m][k],Bt_[n][k],acc[ai][bj][m][n],0,0,0); \
    __builtin_amdgcn_s_setprio(0);}while(0)
#define WAIT_V(n) asm volatile("s_waitcnt vmcnt(" #n ")":::"memory")
#define WAIT_L(n) asm volatile("s_waitcnt lgkmcnt(" #n ")":::"memory")
#define BAR __builtin_amdgcn_s_barrier()
#define SCHED __builtin_amdgcn_sched_barrier(0)
    f32x4 acc[2][2][4][2];
    const auto pre = epi.pre(wc, fq);
    bf16x8 At[4][2], B0[2][2], B1[2][2];
    const size_t ks = (size_t)(BK * 2);
#if GEMM_SP2
    STAGE(SB(0,0),B0p,vb); STAGE(SB(0,1),B1p,vb); STAGE(SA(0,0),A0,va[0]); STAGE(SA(0,1),A1,va[1]);
    if(wr==1)BAR;
    WAIT_V(2); BAR;
    STAGE(SB(1,0),B0p+ks,vb); STAGE(SA(1,0),A0+ks,va[0]); STAGE(SB(1,1),B1p+ks,vb);
    WAIT_V(6); BAR;
    epi.init(acc, pre);
    for(int t=0;t<nt;t+=2){
        const bool last = (t == nt - 2);
        const size_t o1 = (size_t)(t+1)*ks, o2 = last ? 0 : (size_t)(t+2)*ks, o3 = o2 + ks;
        LDB(B0,0,0); LDB(B1,0,1); SCHED; LDA(At,0,0); STAGE(SA(1,1),A1+o1,va[1]);
        WAIT_V(8); WAIT_L(0); BAR; MMA(0,0,At,B0); MMA(0,1,At,B1); BAR; SCHED;
        LDA(At,0,1); STAGE(SB(0,0),B0p+o2,vb); STAGE(SB(0,1),B1p+o2,vb); STAGE(SA(0,0),A0+o2,va[0]);
        WAIT_V(8); WAIT_L(0); BAR; MMA(1,0,At,B0); MMA(1,1,At,B1); BAR; SCHED;
        LDB(B0,1,0); LDB(B1,1,1); SCHED; LDA(At,1,0); STAGE(SA(0,1),A1+o2,va[1]);
        WAIT_V(8); WAIT_L(0); BAR; MMA(0,0,At,B0); MMA(0,1,At,B1); BAR; SCHED;
        LDA(At,1,1); STAGE(SB(1,0),B0p+o3,vb); STAGE(SB(1,1),B1p+o3,vb); STAGE(SA(1,0),A0+o3,va[0]);
        WAIT_V(8); WAIT_L(0); BAR; MMA(1,0,At,B0); MMA(1,1,At,B1); BAR; SCHED;
    }
    WAIT_V(0);
    if(wr==0)BAR;
    BAR;
    epi(acc, wr, wc, fr, fq);
#else
    STAGE(SB(0,0),B0p,vb); STAGE(SA(0,0),A0,va[0]);
    STAGE(SB(0,1),B1p,vb); STAGE(SA(0,1),A1,va[1]);
    if(wr==1)BAR;
    WAIT_V(4); BAR;
    STAGE(SB(1,0),B0p+ks,vb); STAGE(SA(1,0),A0+ks,va[0]); STAGE(SB(1,1),B1p+ks,vb);
    WAIT_V(6); BAR;
    epi.init(acc, pre);
    for(int t=0;t<nt-2;t+=2){
        const char* a0t1 = A0 + (size_t)(t+1)*ks; (void)a0t1;
        const size_t o1 = (size_t)(t+1)*ks, o2 = (size_t)(t+2)*ks, o3 = (size_t)(t+3)*ks;
        LDB(B0,0,0); SCHED; LDA(At,0,0); STAGE(SA(1,1),A1+o1,va[1]);
        WAIT_L(8); BAR; WAIT_L(0); MMA(0,0,At,B0); BAR; SCHED;
        LDB(B1,0,1); STAGE(SB(0,0),B0p+o2,vb);
        BAR; WAIT_L(0); MMA(0,1,At,B1); BAR;
        LDA(At,0,1); STAGE(SA(0,0),A0+o2,va[0]);
        BAR; WAIT_L(0); MMA(1,0,At,B0); BAR; SCHED;
        STAGE(SB(0,1),B1p+o2,vb);
        WAIT_V(6); BAR; MMA(1,1,At,B1); BAR;
        LDB(B0,1,0); SCHED; LDA(At,1,0); STAGE(SA(0,1),A1+o2,va[1]);
        WAIT_L(8); BAR; WAIT_L(0); MMA(0,0,At,B0); BAR; SCHED;
        LDB(B1,1,1); STAGE(SB(1,0),B0p+o3,vb);
        BAR; WAIT_L(0); MMA(0,1,At,B1); BAR;
        LDA(At,1,1); STAGE(SA(1,0),A0+o3,va[0]);
        BAR; WAIT_L(0); MMA(1,0,At,B0); BAR; SCHED;
        STAGE(SB(1,1),B1p+o3,vb);
        WAIT_V(6); BAR; MMA(1,1,At,B1); BAR;
    }
    { LDB(B0,0,0); WAIT_V(0); LDA(At,0,0); STAGE(SA(1,1),A1+(size_t)(nt-1)*ks,va[1]);
      BAR; WAIT_L(0); MMA(0,0,At,B0); BAR;
      LDB(B1,0,1); BAR; WAIT_L(0); MMA(0,1,At,B1); BAR;
      LDA(At,0,1); WAIT_V(4); BAR; WAIT_L(0); MMA(1,0,At,B0); MMA(1,1,At,B1); BAR; }
    { LDB(B0,1,0); LDA(At,1,0); WAIT_V(2); BAR; WAIT_L(0); MMA(0,0,At,B0); BAR;
      LDB(B1,1,1); WAIT_V(0); BAR; WAIT_L(0); MMA(0,1,At,B1); BAR;
      LDA(At,1,1); BAR; WAIT_L(0); MMA(1,0,At,B0); MMA(1,1,At,B1); BAR; }
    if(wr==0)BAR;
    epi(acc, wr, wc, fr, fq);
#endif
#undef SA
#undef SB
#undef STAGE
#undef LDA
#undef LDB
#undef MMA
}

template <bool GATHER, class EPI, class PROV>
DEVFN void gemm_stream(char* smem, const PROV& S, int nt, size_t hstepA, size_t hstepB, int ldA, int ldB) {
    LAS unsigned char* lds = (LAS unsigned char*)smem;
    const int tid = TIDX, wid = __builtin_amdgcn_readfirstlane(tid >> 6), lane = tid & 63, wr = wid >> 2, wc = wid & 3, fr = lane & 15, fq = lane >> 4;
    const unsigned ldsw = (unsigned)wid * 1024u;
    const int aoff = lds_byte(wr * 64 + fr, fq * 8), boff = lds_byte(wc * 32 + fr, fq * 8);
    unsigned vb[2], vaC[2][2], vaN[2][2];
#pragma unroll
    for (int i = 0; i < 2; ++i) { int r, c; stage_rc(tid * 16 + i * 8192, r, c); { const int rr = r & 31, n = rr >> 4, ii = rr & 15, rb = (r & ~31) + 8 * (ii >> 2) + 4 * n + (ii & 3); vb[i] = (unsigned)(rb * ldB + c) * 2u; } vaC[0][i] = vaC[1][i] = vaN[0][i] = vaN[1][i] = (unsigned)(r * ldA + c) * 2u; }
#define SA(b,h) (((b)*2+(h))*HTB)
#define SB(b,h) ((4+(b)*2+(h))*HTB)
#define STAGE(bufoff,gbase,voff) do{ _Pragma("unroll") for(int _i=0;_i<2;++_i) \
      __builtin_amdgcn_global_load_lds((const unsigned*)((const char*)(gbase)+(voff)[_i]), (LAS unsigned*)(lds+(bufoff)+ldsw+_i*8192),16,0,0);}while(0)
#define LDA(dst,b,h) do{ _Pragma("unroll") for(int m=0;m<4;++m) _Pragma("unroll") for(int k=0;k<2;++k) dst[m][k]=*(const LAS bf16x8*)(lds+SA(b,h)+aoff+m*2048+k*1024);}while(0)
#define LDB(dst,b,h) do{ _Pragma("unroll") for(int n=0;n<2;++n) _Pragma("unroll") for(int k=0;k<2;++k) dst[n][k]=*(const LAS bf16x8*)(lds+SB(b,h)+boff+n*2048+k*1024);}while(0)
#define MMA(ai,bj,At_,Bt_) do{__builtin_amdgcn_s_setprio(1); \
    _Pragma("unroll") for(int m=0;m<4;++m) _Pragma("unroll") for(int n=0;n<2;++n) _Pragma("unroll") for(int k=0;k<2;++k) \
      acc[ai][bj][m][n]=__builtin_amdgcn_mfma_f32_16x16x32_bf16(Bt_[n][k],At_[m][k],acc[ai][bj][m][n],0,0,0); \
    __builtin_amdgcn_s_setprio(0);}while(0)
    const char *cA, *cB, *nA, *nB; EPI cE, nE;
    if (!S.next(0, cA, cB, vaC, cE)) return;
    f32x4 acc[2][2][4][2];
#pragma unroll
    for (int a = 0; a < 2; ++a)
#pragma unroll
        for (int b = 0; b < 2; ++b)
#pragma unroll
            for (int m = 0; m < 4; ++m)
#pragma unroll
                for (int n = 0; n < 2; ++n) acc[a][b][m][n] = (f32x4){0.f, 0.f, 0.f, 0.f};
    bf16x8 At[4][2], B0[2][2], B1[2][2];
    const size_t ks = (size_t)(BK * 2);
    STAGE(SB(0,0),cB,vb); STAGE(SA(0,0),cA,vaC[0]); STAGE(SB(0,1),cB+hstepB,vb); STAGE(SA(0,1),cA+hstepA,vaC[1]);
    if(wr==1)BAR;
    WAIT_V(4); BAR;
    STAGE(SB(1,0),cB+ks,vb); STAGE(SA(1,0),cA+ks,vaC[0]); STAGE(SB(1,1),cB+hstepB+ks,vb);
    WAIT_V(6); BAR;
    for (int ui = 0;;) {
        const bool has_next = S.next(ui + 1, nA, nB, vaN, nE);
        if (!has_next) { nA = cA; nB = cB; if (GATHER) {
#pragma unroll
            for (int h = 0; h < 2; ++h)
#pragma unroll
                for (int i = 0; i < 2; ++i) vaN[h][i] = vaC[h][i]; } }
        for (int t = 0; t < nt; t += 2) {
            const bool last = (t == nt - 2);
            const char* a1 = cA + (size_t)(t + 1) * ks;
            const char* a2 = last ? nA : cA + (size_t)(t + 2) * ks; const char* b2 = last ? nB : cB + (size_t)(t + 2) * ks;
            const char* a3 = a2 + ks; const char* b3 = b2 + ks;
            unsigned v2[2][2];
#pragma unroll
            for (int h = 0; h < 2; ++h)
#pragma unroll
                for (int i = 0; i < 2; ++i) v2[h][i] = (GATHER && last) ? vaN[h][i] : vaC[h][i];
            LDB(B0,0,0); SCHED; LDA(At,0,0); STAGE(SA(1,1),a1+hstepA,vaC[1]);
            WAIT_L(8); BAR; WAIT_L(0); MMA(0,0,At,B0); BAR; SCHED;
            LDB(B1,0,1); STAGE(SB(0,0),b2,vb);
            BAR; WAIT_L(0); MMA(0,1,At,B1); BAR;
            LDA(At,0,1); STAGE(SA(0,0),a2,v2[0]);
            BAR; WAIT_L(0); MMA(1,0,At,B0); BAR; SCHED;
            STAGE(SB(0,1),b2+hstepB,vb);
            WAIT_V(6); BAR; MMA(1,1,At,B1); BAR;
            LDB(B0,1,0); SCHED; LDA(At,1,0); STAGE(SA(0,1),a2+hstepA,v2[1]);
            WAIT_L(8); BAR; WAIT_L(0); MMA(0,0,At,B0); BAR; SCHED;
            LDB(B1,1,1); STAGE(SB(1,0),b3,vb);
            BAR; WAIT_L(0); MMA(0,1,At,B1); BAR;
            LDA(At,1,1); STAGE(SA(1,0),a3,v2[0]);
            BAR; WAIT_L(0); MMA(1,0,At,B0); BAR; SCHED;
            STAGE(SB(1,1),b3+hstepB,vb);
            WAIT_V(6); BAR; MMA(1,1,At,B1); BAR;
        }
        cE(acc, wr, wc, fr, fq);
        if (!has_next) break;
#pragma unroll
        for (int a = 0; a < 2; ++a)
#pragma unroll
            for (int b = 0; b < 2; ++b)
#pragma unroll
                for (int m = 0; m < 4; ++m)
#pragma unroll
                    for (int n = 0; n < 2; ++n) acc[a][b][m][n] = (f32x4){0.f, 0.f, 0.f, 0.f};
        cA = nA; cB = nB; cE = nE; ++ui;
        if (GATHER) {
#pragma unroll
            for (int h = 0; h < 2; ++h)
#pragma unroll
                for (int i = 0; i < 2; ++i) vaC[h][i] = vaN[h][i]; }
    }
    WAIT_V(0);
    if (wr == 0) BAR;
    BAR;
#undef SA
#undef SB
#undef STAGE
#undef LDA
#undef LDB
#undef MMA
}

DEVFN void lin_voff(unsigned (&v)[2], int ld) {
#pragma unroll
    for (int i = 0; i < 2; ++i) { int r, c; stage_rc((int)TIDX * 16 + i * 8192, r, c); v[i] = (unsigned)(r * ld + c) * 2u; }
}
DEVFN void lin_voff_b(unsigned (&v)[2], int ld) {
#pragma unroll
    for (int i = 0; i < 2; ++i) { int r, c; stage_rc(TIDX * 16 + i * 8192, r, c); const int rr = r & 31, n = rr >> 4, ii = rr & 15, rb = (r & ~31) + 8 * (ii >> 2) + 4 * n + (ii & 3); v[i] = (unsigned)(rb * ld + c) * 2u; }
}
DEVFN bool tile_from_index(long L, int nM, int nN, int& pm, int& pn) {
    const int nwg = nM * nN; if (L >= nwg) return false;
    int wgid = (int)L; { const int q = nwg / 8, r = nwg % 8, xcd = wgid % 8, off = wgid / 8; wgid = (xcd < r ? xcd * (q + 1) : r * (q + 1) + (xcd - r) * q) + off; }
    const int nig = 8 * nN, gid = wgid / nig, fm = gid * 8, gsz = (nM - fm) < 8 ? (nM - fm) : 8;
    pm = fm + ((wgid % nig) % gsz); pn = (wgid % nig) / gsz; return true;
}
DEVFN bool tile_order(int it, int nM, int nN, int& pm, int& pn) { return tile_from_index((long)it * gridDim.x + blockIdx.x, nM, nN, pm, pn); }

struct NoPre {};
DEVFN void acc_zero(f32x4 (&acc)[2][2][4][2]) {
#pragma unroll
    for (int a = 0; a < 2; ++a)
#pragma unroll
        for (int b = 0; b < 2; ++b)
#pragma unroll
            for (int m = 0; m < 4; ++m)
#pragma unroll
                for (int n = 0; n < 2; ++n) acc[a][b][m][n] = (f32x4){0.f, 0.f, 0.f, 0.f};
}
struct BiasPre { f32x4 b[2][2]; };
DEVFN void acc_bias(f32x4 (&acc)[2][2][4][2], const BiasPre& pre) {
#pragma unroll
    for (int a = 0; a < 2; ++a)
#pragma unroll
        for (int b = 0; b < 2; ++b)
#pragma unroll
            for (int m = 0; m < 4; ++m)
#pragma unroll
                for (int n = 0; n < 2; ++n) acc[a][b][m][n] = pre.b[b][n];
}
#define EPI_NOPRE DEVFN NoPre pre(int, int) const { return NoPre{}; } DEVFN void init(f32x4 (&acc)[2][2][4][2], const NoPre&) const { acc_zero(acc); }
DEVFN u32x4 pack8(const f32x4& a, const f32x4& b) { u32x4 w; w.x = pk2(a[0], a[1]); w.y = pk2(a[2], a[3]); w.z = pk2(b[0], b[1]); w.w = pk2(b[2], b[3]); return w; }
struct EpiQK {
    bf16_t* dst; int row0, col0; float scale;
    EPI_NOPRE
    DEVFN void operator()(const f32x4 (&acc)[2][2][4][2], int wr, int wc, int fr, int fq) const {
#pragma unroll
        for (int ai = 0; ai < 2; ++ai)
#pragma unroll
            for (int m = 0; m < 4; ++m) { const int row = row0 + ai * 128 + wr * 64 + m * 16 + fr;
#pragma unroll
                for (int bj = 0; bj < 2; ++bj) { const int col = col0 + bj * 128 + wc * 32 + 8 * fq;
                    *(u32x4*)(dst + (size_t)row * DM + col) = pack8(acc[ai][bj][m][0] * scale, acc[ai][bj][m][1] * scale); } }
    }
};
struct EpiVt {
    bf16_t* vtl; bf16_t* vtc; int row0, vc0;
    EPI_NOPRE
    DEVFN void operator()(const f32x4 (&acc)[2][2][4][2], int wr, int wc, int fr, int fq) const {
#pragma unroll
        for (int ai = 0; ai < 2; ++ai)
#pragma unroll
            for (int m = 0; m < 4; ++m) { const int row = row0 + ai * 128 + wr * 64 + m * 16 + 4 * fq;
                bf16_t* base; if (row < TL) { const int t = row & (SEQ - 1); base = vtl + (size_t)(row >> 12) * DM * SEQ + (t >> 3) * 512 + (t & 7); } else { const int rr = row - TL, t = rr & (CTXL - 1); base = vtc + (size_t)(rr >> 8) * DM * CTXL + (t >> 3) * 512 + (t & 7); }
                const size_t ld = row < TL ? SEQ : CTXL;
#pragma unroll
                for (int bj = 0; bj < 2; ++bj)
#pragma unroll
                    for (int n = 0; n < 2; ++n) { const int vc = vc0 + bj * 128 + wc * 32 + 8 * (fr >> 2) + 4 * n + (fr & 3); const f32x4 v = acc[ai][bj][m][n];
                        u32x2 w; w.x = pk2(v[0], v[1]); w.y = pk2(v[2], v[3]); *(u32x2*)(base + (size_t)(vc >> 6) * 64 * ld + (vc & 63) * 8) = w; } }
    }
};
struct EpiBf16 {
    bf16_t* dst; int ldc, row0, col0; const float* bias; int gelu; LAS float* stg;
    EPI_NOPRE
    DEVFN void stage() const { const int t = TIDX; if (t < 64) *(LAS f32x4*)(stg + 4 * t) = *(const f32x4*)(bias + col0 + 4 * t); }
    DEVFN void operator()(const f32x4 (&acc)[2][2][4][2], int wr, int wc, int fr, int fq) const {
        f32x4 bv[2][2];
#pragma unroll
        for (int bj = 0; bj < 2; ++bj)
#pragma unroll
            for (int n = 0; n < 2; ++n) bv[bj][n] = *(const LAS f32x4*)(stg + bj * 128 + wc * 32 + 8 * fq + 4 * n);
#pragma unroll
        for (int ai = 0; ai < 2; ++ai)
#pragma unroll
            for (int m = 0; m < 4; ++m) { const int row = row0 + ai * 128 + wr * 64 + m * 16 + fr;
#pragma unroll
                for (int bj = 0; bj < 2; ++bj) { const int col = col0 + bj * 128 + wc * 32 + 8 * fq; f32x4 v0 = acc[ai][bj][m][0] + bv[bj][0], v1 = acc[ai][bj][m][1] + bv[bj][1];
                    if (gelu) { const f32x2 a = gelu_pk((f32x2){v0[0], v0[1]}), b = gelu_pk((f32x2){v0[2], v0[3]}), c = gelu_pk((f32x2){v1[0], v1[1]}), d = gelu_pk((f32x2){v1[2], v1[3]});
                        v0 = (f32x4){a.x, a.y, b.x, b.y}; v1 = (f32x4){c.x, c.y, d.x, d.y}; }
                    *(u32x4*)(dst + (size_t)row * ldc + col) = pack8(v0, v1); } }
    }
};
struct EpiResid {
    bf16_t* X; const float* gate; const float* bias; int row0, col0; int dry;
    EPI_NOPRE
    DEVFN void operator()(const f32x4 (&acc)[2][2][4][2], int wr, int wc, int fr, int fq) const {
        const int mr = row0 < TL ? (row0 >> 12) : 8;
        f32x4 bv[2][2], gv[2][2];
#pragma unroll
        for (int bj = 0; bj < 2; ++bj)
#pragma unroll
            for (int n = 0; n < 2; ++n) { const int col = col0 + bj * 128 + wc * 32 + 8 * fq + 4 * n;
                bv[bj][n] = bias ? *(const f32x4*)(bias + col) : (f32x4){0.f, 0.f, 0.f, 0.f}; gv[bj][n] = *(const f32x4*)(gate + (size_t)mr * 6144 + col); }
#pragma unroll
        for (int ai = 0; ai < 2; ++ai)
#pragma unroll
            for (int m = 0; m < 4; ++m) { const int row = row0 + ai * 128 + wr * 64 + m * 16 + fr;
#pragma unroll
                for (int bj = 0; bj < 2; ++bj) { const int col = col0 + bj * 128 + wc * 32 + 8 * fq; u32x4* px = (u32x4*)(X + (size_t)row * DM + col); const u32x4 xo = *px;
                    const f32x4 n0 = (f32x4){bflo(xo.x), bfhi(xo.x), bflo(xo.y), bfhi(xo.y)} + gv[bj][0] * (acc[ai][bj][m][0] + bv[bj][0]);
                    const f32x4 n1 = (f32x4){bflo(xo.z), bfhi(xo.z), bflo(xo.w), bfhi(xo.w)} + gv[bj][1] * (acc[ai][bj][m][1] + bv[bj][1]);
                    if (!dry || n0[0] == 1.2345678e-33f) *px = pack8(n0, n1); } }
    }
};
struct EpiSwiglu {
    bf16_t* dst; int row0, cg0; const float* bgu; int dry;
    DEVFN BiasPre pre(int wc, int fq) const { BiasPre r;
#pragma unroll
        for (int n = 0; n < 2; ++n) { const int col = cg0 + wc * 32 + 8 * fq + 4 * n; r.b[0][n] = *(const f32x4*)(bgu + col); r.b[1][n] = *(const f32x4*)(bgu + 1024 + col) + 1.0f; }
        return r; }
    DEVFN void init(f32x4 (&acc)[2][2][4][2], const BiasPre& pre) const { acc_bias(acc, pre); }
    DEVFN void operator()(const f32x4 (&acc)[2][2][4][2], int wr, int wc, int fr, int fq) const {
#pragma unroll
        for (int ai = 0; ai < 2; ++ai)
#pragma unroll
            for (int m = 0; m < 4; ++m) { const int row = row0 + ai * 128 + wr * 64 + m * 16 + fr; f32x4 o[2];
#pragma unroll
                for (int n = 0; n < 2; ++n) { const f32x4 g = acc[ai][0][m][n], l = acc[ai][1][m][n];
#pragma unroll
                    for (int j = 0; j < 4; ++j) { const float xg = fminf(g[j], 7.0f), xl1 = fminf(fmaxf(l[j], -6.0f), 8.0f);
                        const float sg = __builtin_amdgcn_rcpf(1.0f + __builtin_amdgcn_exp2f(-1.702f * 1.44269504f * xg)); o[n][j] = xg * sg * xl1; } }
                const u32x4 w = pack8(o[0], o[1]); if (!dry || w.x == 0x12345u) *(u32x4*)(dst + (size_t)row * DM + cg0 + wc * 32 + 8 * fq) = w; }
    }
};
struct EpiMoeDn {
    bf16_t* dst; int row0, col0; const float* bias; const float* gates; int cnt, rb, dry;
    DEVFN BiasPre pre(int wc, int fq) const { BiasPre r;
#pragma unroll
        for (int bj = 0; bj < 2; ++bj)
#pragma unroll
            for (int n = 0; n < 2; ++n) r.b[bj][n] = *(const f32x4*)(bias + col0 + bj * 128 + wc * 32 + 8 * fq + 4 * n);
        return r; }
    DEVFN void init(f32x4 (&acc)[2][2][4][2], const BiasPre& pre) const { acc_bias(acc, pre); }
    DEVFN void operator()(const f32x4 (&acc)[2][2][4][2], int wr, int wc, int fr, int fq) const {
#pragma unroll
        for (int ai = 0; ai < 2; ++ai)
#pragma unroll
            for (int m = 0; m < 4; ++m) { const int rl = ai * 128 + wr * 64 + m * 16 + fr; const int pos = rb * 256 + rl; const float gt = pos < cnt ? gates[pos] : 0.f;
#pragma unroll
                for (int bj = 0; bj < 2; ++bj) { const int col = col0 + bj * 128 + wc * 32 + 8 * fq;
                    const u32x4 w = pack8(acc[ai][bj][m][0] * gt, acc[ai][bj][m][1] * gt);
                    if (!dry || w.x == 0x12345u) *(u32x4*)(dst + (size_t)(row0 + rl) * DM + col) = w; } }
    }
};

struct EpiVtG {
    bf16_t* vt; float* stat; const float* bias; int row0, col0;
    EPI_NOPRE
    DEVFN void operator()(const f32x4 (&acc)[2][2][4][2], int wr, int wc, int fr, int fq) const {
#pragma unroll
        for (int bj = 0; bj < 2; ++bj) {
            const int tok0 = col0 + bj * 128, chunk = tok0 >> 7, q0 = wc * 32 + 8 * fq;
            float s[8], ss[8];
#pragma unroll
            for (int e = 0; e < 8; ++e) { s[e] = 0.f; ss[e] = 0.f; }
#pragma unroll
            for (int ai = 0; ai < 2; ++ai)
#pragma unroll
                for (int m = 0; m < 4; ++m) { const int ch = row0 + ai * 128 + wr * 64 + m * 16 + fr; const float bch = bias[ch];
                    f32x4 v0 = acc[ai][bj][m][0] + bch, v1 = acc[ai][bj][m][1] + bch;
                    { const f32x2 a = gelu_pk((f32x2){v0[0], v0[1]}), b = gelu_pk((f32x2){v0[2], v0[3]}), c = gelu_pk((f32x2){v1[0], v1[1]}), d = gelu_pk((f32x2){v1[2], v1[3]});
                      v0 = (f32x4){a.x, a.y, b.x, b.y}; v1 = (f32x4){c.x, c.y, d.x, d.y}; }
                    *(u32x4*)(vt + ((size_t)chunk * 3072 + ch) * 128 + q0) = pack8(v0, v1);
#pragma unroll
                    for (int j = 0; j < 4; ++j) { s[j] += v0[j]; ss[j] += v0[j] * v0[j]; s[4 + j] += v1[j]; ss[4 + j] += v1[j] * v1[j]; } }
#define RS8(n, x) { const bool hi = (fr & (x)) != 0; _Pragma("unroll") for (int k = 0; k < (n); ++k) { \
                const float g1 = hi ? s[k] : s[k + (n)], k1 = hi ? s[k + (n)] : s[k]; s[k] = k1 + __shfl_xor(g1, (x)); \
                const float g2 = hi ? ss[k] : ss[k + (n)], k2 = hi ? ss[k + (n)] : ss[k]; ss[k] = k2 + __shfl_xor(g2, (x)); } }
            RS8(4, 8) RS8(2, 4) RS8(1, 2)
#undef RS8
            const float ts = s[0] + __shfl_xor(s[0], 1), tss = ss[0] + __shfl_xor(ss[0], 1);
            const int e = ((fr >> 3) & 1) * 4 + ((fr >> 2) & 1) * 2 + ((fr >> 1) & 1);
            stat[((size_t)(tok0 + q0 + e) * 24 + (row0 >> 8) * 2 + wr) * 2 + (fr & 1)] = (fr & 1) ? tss : ts;
        }
    }
};

DEVFN void conv_unit(char* smem, const float* __restrict__ W, bf16_t* __restrict__ out, int K, int N, int unit, int perm) {
    float* tile = (float*)smem;
    const int tid = TIDX, nN = N >> 8, kt = unit / nN, nt = unit - kt * nN, k0 = kt * 64, n0 = nt * 256;
#pragma unroll
    for (int i = 0; i < 8; ++i) { const int idx = tid + 512 * i, r = idx >> 6, c4 = idx & 63;
        const f32x4 v = *(const f32x4*)(W + (size_t)(k0 + r) * N + n0 + 4 * c4); *(f32x4*)(tile + r * 260 + 4 * c4) = v; }
    __syncthreads();
    const int n = tid >> 1, kh = tid & 1;
    unsigned pk[16];
#pragma unroll
    for (int j = 0; j < 16; ++j) pk[j] = pk2(tile[(32 * kh + 2 * j) * 260 + n], tile[(32 * kh + 2 * j + 1) * 260 + n]);
    const int nn = n0 + n;
    const int no = perm ? ((nn < 1024) ? ((nn >> 7) * 256 + (nn & 127)) : ((((nn - 1024) >> 7) * 256) + 128 + (nn & 127))) : nn;
    u32x4* dst = (u32x4*)(out + (size_t)no * K + k0 + 32 * kh);
#pragma unroll
    for (int j = 0; j < 4; ++j) dst[j] = (u32x4){pk[4 * j], pk[4 * j + 1], pk[4 * j + 2], pk[4 * j + 3]};
    __syncthreads();
}
template <int SH, int N, int PERM>
DEVFN void conv_stream(char* smem, const float* __restrict__ W0, bf16_t* __restrict__ out0, int nunits) {
    constexpr int K = 1024, nN = N >> 8;
    float* tile = (float*)smem;
    const int tid = TIDX, G = gridDim.x;
    f32x4 buf[8];
    int u = blockIdx.x;
    if (u < nunits) { const int le = u >> SH, unit = u & ((1 << SH) - 1), kt = unit / nN, nt = unit - kt * nN; const float* W = W0 + (size_t)le * K * N + (size_t)(kt * 64) * N + nt * 256;
#pragma unroll
        for (int i = 0; i < 8; ++i) { const int idx = tid + 512 * i, r = idx >> 6, c4 = idx & 63; buf[i] = *(const f32x4*)(W + (size_t)r * N + 4 * c4); } }
    while (u < nunits) {
#pragma unroll
        for (int i = 0; i < 8; ++i) { const int idx = tid + 512 * i, r = idx >> 6, c4 = idx & 63; *(f32x4*)(tile + r * 260 + 4 * c4) = buf[i]; }
        __syncthreads();
        const int un = u + G;
        if (un < nunits) { const int le = un >> SH, unit = un & ((1 << SH) - 1), kt = unit / nN, nt = unit - kt * nN; const float* W = W0 + (size_t)le * K * N + (size_t)(kt * 64) * N + nt * 256;
#pragma unroll
            for (int i = 0; i < 8; ++i) { const int idx = tid + 512 * i, r = idx >> 6, c4 = idx & 63; buf[i] = *(const f32x4*)(W + (size_t)r * N + 4 * c4); } }
        { const int le = u >> SH, unit = u & ((1 << SH) - 1), kt = unit / nN, nt = unit - kt * nN, k0 = kt * 64, n0 = nt * 256;
          const int n = tid >> 1, kh = tid & 1;
          unsigned pk[16];
#pragma unroll
          for (int j = 0; j < 16; ++j) pk[j] = pk2(tile[(32 * kh + 2 * j) * 260 + n], tile[(32 * kh + 2 * j + 1) * 260 + n]);
          const int nn = n0 + n;
          const int no = PERM ? ((nn < 1024) ? ((nn >> 7) * 256 + (nn & 127)) : ((((nn - 1024) >> 7) * 256) + 128 + (nn & 127))) : nn;
          u32x4* dst = (u32x4*)(out0 + (size_t)le * N * K + (size_t)no * K + k0 + 32 * kh);
#pragma unroll
          for (int j = 0; j < 4; ++j) dst[j] = (u32x4){pk[4 * j], pk[4 * j + 1], pk[4 * j + 2], pk[4 * j + 3]}; }
        __syncthreads();
        u = un;
    }
}
constexpr int WQ_GU = 32 * 128, WQ_UNITS = WQ_GU + 32 * 64;
#ifndef FILL_IN
#define FILL_IN 6
#endif
#ifndef FILL_OUT
#define FILL_OUT 9
#endif
#ifndef FILL_OUT3
#define FILL_OUT3 21
#endif
#ifndef FILL_MOE
#define FILL_MOE 6
#endif
DEVFN void conv_range(const Params& p, char* smem, int l, int q0, int q1) {
    float* tile = (float*)smem;
    const int tid = TIDX;
    f32x4 buf[8];
#define CQ_DECODE(q_) const bool gu = (q_) < WQ_GU; const int rr = gu ? (q_) : (q_) - WQ_GU; const int N = gu ? 2048 : 1024; \
        const int le = l * 32 + (gu ? rr >> 7 : rr >> 6), unit = gu ? (rr & 127) : (rr & 63), kt = gu ? unit >> 3 : unit >> 2, nt = gu ? (unit & 7) : (unit & 3);
#define CQ_LOAD(q_) { CQ_DECODE(q_) const float* W = (gu ? p.moe_w_gu : p.moe_w_dn) + (size_t)le * 1024 * N + (size_t)(kt * 64) * N + nt * 256; \
        _Pragma("unroll") for (int i = 0; i < 8; ++i) { const int idx = tid + 512 * i, r = idx >> 6, c4 = idx & 63; buf[i] = *(const f32x4*)(W + (size_t)r * N + 4 * c4); } }
    int q = q0;
    if (q < q1) CQ_LOAD(q)
    while (q < q1) {
#pragma unroll
        for (int i = 0; i < 8; ++i) { const int idx = tid + 512 * i, r = idx >> 6, c4 = idx & 63; *(f32x4*)(tile + r * 260 + 4 * c4) = buf[i]; }
        __syncthreads();
        if (q + 1 < q1) CQ_LOAD(q + 1)
        { CQ_DECODE(q) const int k0 = kt * 64, n0 = nt * 256, n = tid >> 1, kh = tid & 1;
          unsigned pk[16];
#pragma unroll
          for (int j = 0; j < 16; ++j) pk[j] = pk2(tile[(32 * kh + 2 * j) * 260 + n], tile[(32 * kh + 2 * j + 1) * 260 + n]);
          const int nn = n0 + n;
          const int no = gu ? ((nn < 1024) ? ((nn >> 7) * 256 + (nn & 127)) : ((((nn - 1024) >> 7) * 256) + 128 + (nn & 127))) : nn;
          u32x4* dst = (u32x4*)((gu ? p.MOEGU : p.MOEDN) + (size_t)le * N * 1024 + (size_t)no * 1024 + k0 + 32 * kh);
#pragma unroll
          for (int j = 0; j < 4; ++j) dst[j] = (u32x4){pk[4 * j], pk[4 * j + 1], pk[4 * j + 2], pk[4 * j + 3]}; }
        __syncthreads();
        ++q;
    }
#undef CQ_DECODE
#undef CQ_LOAD
}
DEVFN void conv_fill(const Params& p, char* smem, int lmin, int budget) {
    if (lmin > 3 || budget <= 0) return;
    int* slot = (int*)(smem + 67584);
    __syncthreads();
    if (TIDX == 0) { int l = lmin, q0;
        for (;;) { q0 = __hip_atomic_fetch_add(p.cnt + 128 + l, budget, __ATOMIC_RELAXED, __HIP_MEMORY_SCOPE_AGENT); if (q0 < WQ_UNITS || l == 3) break; ++l; }
        slot[0] = q0; slot[1] = l; }
    __syncthreads();
    const int q0 = __builtin_amdgcn_readfirstlane(slot[0]), l = __builtin_amdgcn_readfirstlane(slot[1]);
    conv_range(p, smem, l, q0, min(q0 + budget, WQ_UNITS));
}
DEVFN void conv_drain(const Params& p, char* smem, int l) {
    int* slot = (int*)(smem + 67584);
    for (;;) {
        __syncthreads();
        if (TIDX == 0) slot[0] = __hip_atomic_fetch_add(p.cnt + 128 + l, 4, __ATOMIC_RELAXED, __HIP_MEMORY_SCOPE_AGENT);
        __syncthreads();
        const int q0 = __builtin_amdgcn_readfirstlane(slot[0]);
        if (q0 >= WQ_UNITS) break;
        conv_range(p, smem, l, q0, min(q0 + 4, WQ_UNITS));
    }
    __syncthreads();
}
DEVFN void mod_unit(char* smem, const Params& p, int unit) {
    float* s = (float*)smem;
    float* red = s + 9 * 1024;
    const int tid = TIDX, layer = unit / 48, cb = unit % 48, nl = tid & 127, n = cb * 128 + nl, kq = tid >> 7;
    for (int idx = tid; idx < 9 * 1024; idx += NTHREADS) { const int r = idx >> 10, k = idx & 1023; const float v = r < 8 ? p.c[r * 1024 + k] : p.c_ctx[k]; s[idx] = v / (1.0f + __expf(-v)); }
    __syncthreads();
    float acc[9];
#pragma unroll
    for (int r = 0; r < 9; ++r) acc[r] = 0.f;
    const float* w = p.ada_w + ((size_t)layer * 1024 + kq * 256) * 6144 + n;
#pragma unroll 16
    for (int k = 0; k < 256; ++k) { const float wv = w[(size_t)k * 6144];
#pragma unroll
        for (int r = 0; r < 9; ++r) acc[r] += s[r * 1024 + kq * 256 + k] * wv; }
#pragma unroll
    for (int r = 0; r < 9; ++r) red[(kq * 9 + r) * 128 + nl] = acc[r];
    __syncthreads();
    if (kq == 0) {
#pragma unroll
        for (int r = 0; r < 9; ++r) { const float v = ((red[r * 128 + nl] + red[(9 + r) * 128 + nl]) + (red[(18 + r) * 128 + nl] + red[(27 + r) * 128 + nl])) + p.ada_b[layer * 6144 + n];
            p.MOD[((size_t)layer * 9 + r) * 6144 + n] = v; }
    }
    __syncthreads();
}
DEVFN void hya_pos(const Params& p, int pg, int lane) {
    const int L = pg < SEQ ? SEQ : CTXL, pos = pg < SEQ ? pg : pg - SEQ;
    const float t = (float)pos / (float)(L - 1), w = 6.283185307179586f * (float)pos / (float)L;
    float z = 0.f;
    if (lane == 0) z = t;
    else if (lane <= 16) { const float f = 1e-4f + (float)(lane - 1) * ((15.0f - 1e-4f) / 15.0f); z = cosf(f * w); }
    else if (lane <= 32) { const float f = 1e-4f + (float)(lane - 17) * ((15.0f - 1e-4f) / 15.0f); z = -sinf(f * w); }
    const float fr = p.hy_f_freq[lane];
    float a = p.hy_f_b1[lane];
    for (int i = 0; i < 33; ++i) a += __shfl(z, i) * p.hy_f_w1[i * 64 + lane];
    a = sinf(fr * a);
    float a2 = p.hy_f_b2[lane];
    for (int i = 0; i < 64; ++i) a2 += __shfl(a, i) * p.hy_f_w2[i * 64 + lane];
    a2 = sinf(fr * a2);
    float a3 = p.hy_f_b3[lane];
    for (int i = 0; i < 64; ++i) a3 += __shfl(a2, i) * p.hy_f_w3[i * 64 + lane];
    a3 = sinf(fr * a3);
    p.FA[(size_t)pg * 64 + lane] = a3;
}
DEVFN void phase_p0(const Params& p, char* smem) {
    const int G = gridDim.x, bid = blockIdx.x, tid = TIDX;
    if (bid == 0 && tid < 144) p.cnt[tid] = 0;
    for (int u = bid; u < 192; u += G) mod_unit(smem, p, u);
    for (int pg = bid * 8 + (tid >> 6); pg < SEQ + CTXL; pg += G * 8) hya_pos(p, pg, tid & 63);
    for (int u = bid; u < 2 * 192; u += G) { const int j = u / 192; conv_unit(smem, p.na_w_qkv + (size_t)j * 1024 * 3072, p.WQKV + (size_t)j * 3072 * 1024, 1024, 3072, u % 192, 0); }
    for (int u = bid; u < 2 * 64; u += G) { const int j = u / 64; conv_unit(smem, p.na_w_o + (size_t)j * 1024 * 1024, p.WO + (size_t)j * 1024 * 1024, 1024, 1024, u % 64, 0); }
    for (int u = bid; u < 192; u += G) conv_unit(smem, p.hy_w_in, p.HYIN, 1024, 3072, u, 0);
    for (int u = bid; u < 64; u += G) conv_unit(smem, p.hy_w_out, p.HYOUT, 1024, 1024, u, 0);
    for (int u = bid; u < 384; u += G) conv_unit(smem, p.gm_w_in, p.GMIN, 1024, 6144, u, 0);
    for (int u = bid; u < 192; u += G) conv_unit(smem, p.gm_w_out, p.GMOUT, 3072, 1024, u, 0);
    for (int i = bid * NTHREADS + tid; i < 16 * 128 * 128 / 2; i += G * NTHREADS) { const f32x2 v = *(const f32x2*)(p.gm_w_s + 2 * (size_t)i); ((unsigned*)p.GMWS)[i] = pk2(v.x, v.y); }
    for (int i = bid * NTHREADS + tid; i < 16 * 128; i += G * NTHREADS) { const f32x4* w = (const f32x4*)(p.gm_w_s + (size_t)i * 128); float s = 0.f;
#pragma unroll 4
        for (int k = 0; k < 32; ++k) { const f32x4 v = w[k]; s += (v[0] + v[1]) + (v[2] + v[3]); }
        p.GMS0[i] = s; }
    conv_stream<7, 2048, 1>(smem, p.moe_w_gu, p.MOEGU, 32 * 128);
    conv_stream<6, 1024, 0>(smem, p.moe_w_dn, p.MOEDN, 32 * 64);
}

DEVFN void norm_mod_store(const f32x4 (&v)[4], const float* __restrict__ g, const float* __restrict__ sh, const float* __restrict__ sc, bf16_t* __restrict__ orow, int lane, f32x4 (&h)[4]) {
    float ss = 0.f;
#pragma unroll
    for (int i = 0; i < 4; ++i) ss += (v[i][0] * v[i][0] + v[i][1] * v[i][1]) + (v[i][2] * v[i][2] + v[i][3] * v[i][3]);
    const float r = rsqrtf(wave_sum(ss) * (1.0f / DM) + 1e-6f);
#pragma unroll
    for (int i = 0; i < 4; ++i) { const int c = 4 * lane + 256 * i; const f32x4 gv = *(const f32x4*)(g + c), s1 = *(const f32x4*)(sh + c), s2 = *(const f32x4*)(sc + c);
        h[i] = (v[i] * r * gv) * (s2 + 1.0f) + s1;
        u32x2 w; w.x = pk2(h[i][0], h[i][1]); w.y = pk2(h[i][2], h[i][3]); *(u32x2*)(orow + c) = w; }
}
DEVFN void phase_n1_first(const Params& p) {
    const int lane = TIDX & 63, gw = blockIdx.x * 8 + (TIDX >> 6), NW = gridDim.x * 8;
    for (int tok = gw; tok < TT; tok += NW) {
        const float* src = tok < TL ? p.x + (size_t)tok * DM : p.ctx + (size_t)(tok - TL) * DM; const int mr = tok < TL ? (tok >> 12) : 8;
        f32x4 v[4], h[4];
#pragma unroll
        for (int i = 0; i < 4; ++i) { v[i] = *(const f32x4*)(src + 4 * lane + 256 * i); u32x2 w; w.x = pk2(v[i][0], v[i][1]); w.y = pk2(v[i][2], v[i][3]); *(u32x2*)(p.X + (size_t)tok * DM + 4 * lane + 256 * i) = w; }
        const float* mod = p.MOD + (size_t)mr * 6144;
        norm_mod_store(v, p.norm1_g, mod, mod + 1024, p.HX + (size_t)tok * DM, lane, h);
    }
}
template <int L>
DEVFN void hyb_unit(const Params& p, char* smem, int unit) {
    float* wl = (float*)smem;
    float* red = wl + 512;
    float* nrm = red + 32;
    bf16_t* rkl = (bf16_t*)(smem + 4096);
    const int tid = TIDX, d0 = unit * 4, posbase = (L == SEQ) ? 0 : SEQ;
    { const int i = tid >> 3, q = tid & 7; wl[tid] = p.hy_f_wout[(size_t)i * 2048 + (q < 4 ? d0 + q : 1024 + d0 + q - 4)]; }
    if (L == SEQ && tid < 4) rkl[tid * 8192 + 8191] = 0;
    __syncthreads();
    const float dlo = logf(0.3f) / 0.01f, dhi = logf(1.5f) / 0.01f;
    float ad[4];
#pragma unroll
    for (int cc = 0; cc < 4; ++cc) ad[cc] = fabsf(dlo + (float)(d0 + cc) * ((dhi - dlo) / 1023.0f));
    for (int pass = 0; pass < 2; ++pass) {
        float asum[4] = {0.f, 0.f, 0.f, 0.f}, inv[4];
#pragma unroll
        for (int cc = 0; cc < 4; ++cc) inv[cc] = pass ? 1.0f / nrm[cc] : 0.f;
#pragma unroll 1
        for (int t = tid; t < L; t += NTHREADS) {
            const f32x4* fa = (const f32x4*)(p.FA + (size_t)(posbase + t) * 64);
            f32x4 hf = (f32x4){0.f, 0.f, 0.f, 0.f}, hb = hf;
            int woff = 0; asm volatile("" : "+v"(woff));
            const float* wlp = wl + woff;
#pragma unroll 2
            for (int i4 = 0; i4 < 16; ++i4) { const f32x4 a = fa[i4];
#pragma unroll
                for (int j = 0; j < 4; ++j) { const f32x4 w0 = *(const f32x4*)(wlp + (4 * i4 + j) * 8), w1 = *(const f32x4*)(wlp + (4 * i4 + j) * 8 + 4); hf += w0 * a[j]; hb += w1 * a[j]; } }
            const float tn = (float)t / (float)(L - 1);
#pragma unroll
            for (int cc = 0; cc < 4; ++cc) { const float dec = expf(-tn * ad[cc]); const float f = hf[cc] * dec, bk = hb[cc] * dec;
                if (pass == 0) asum[cc] += (t == 0) ? fabsf(f + bk) : (fabsf(f) + fabsf(bk));
                else if (L == SEQ) {
                    bf16_t* row = rkl + cc * 8192;
                    if (t == 0) row[4095] = (bf16_t)(pk2((f + bk) * inv[cc], 0.f) & 0xffff);
                    else { const unsigned w = pk2(f * inv[cc], bk * inv[cc]); row[4095 - t] = (bf16_t)(w & 0xffff); row[4095 + t] = (bf16_t)(w >> 16); }
                } else {
                    float* row = p.KC + (size_t)(d0 + cc) * (2 * L);
                    if (t == 0) { row[L] = (f + bk) * inv[cc]; row[0] = 0.f; } else { row[L + t] = f * inv[cc]; row[L - t] = bk * inv[cc]; }
                } }
        }
        if (pass == 0) {
#pragma unroll
            for (int cc = 0; cc < 4; ++cc) { const float s = wave_sum(asum[cc]); if ((tid & 63) == 0) red[(tid >> 6) * 4 + cc] = s; }
            __syncthreads();
            if (tid < 4) { float s = 0.f; for (int w = 0; w < 8; ++w) s += red[w * 4 + tid]; nrm[tid] = s; }
            __syncthreads();
        }
    }
    __syncthreads();
    if (L == SEQ) {
#pragma unroll 1
        for (int it = tid; it < 16384; it += NTHREADS) { const int w8 = it & 1023, sg = (it >> 10) & 3, cc = it >> 12; const bf16_t* row = rkl + cc * 8192; const int u = 8 * w8 + sg;
            unsigned short e[8];
#pragma unroll
            for (int k = 0; k < 8; ++k) e[k] = (u + k < 8192) ? row[u + k] : (unsigned short)0;
            u32x4 o; o.x = e[0] | ((unsigned)e[1] << 16); o.y = e[2] | ((unsigned)e[3] << 16); o.z = e[4] | ((unsigned)e[5] << 16); o.w = e[6] | ((unsigned)e[7] << 16);
            *(u32x4*)(p.RK4 + ((size_t)(d0 + cc) * 4 + sg) * 8192 + 8 * w8) = o; }
        __syncthreads();
    }
}

template <bool LOCAL, int MODE = 0>
DEVFN void attn_unit(const bf16_t* __restrict__ Q, const bf16_t* __restrict__ Kb, const bf16_t* __restrict__ VtL, const bf16_t* __restrict__ VtC, bf16_t* __restrict__ O,
                     const LAS float* bias, LAS unsigned char* qlds, int b, int R, int h, int jb, int lane) {
    constexpr int NL = LOCAL ? 11 : 0, NG = NL + 8, PD = 1;
    constexpr float L2E = 1.44269504f;
    const int q = lane & 15, g = lane >> 4;
    const int W0 = LOCAL ? min(max(R - 4, 0), 53) : 0, bs = LOCAL ? min(max(16 * jb - 8, 0), 32) : 0;
    int qtok[4];
#pragma unroll
    for (int i = 0; i < 4; ++i) qtok[i] = LOCAL ? (b * SEQ + (R + i) * 64 + 16 * jb) : (TL + b * CTXL + 16 * (4 * jb + i));
    { bf16x8 qt[4][2];
#pragma unroll
      for (int i = 0; i < 4; ++i)
#pragma unroll
        for (int kk = 0; kk < 2; ++kk) qt[i][kk] = *(const bf16x8*)(Q + (size_t)(qtok[i] + q) * DM + h * 64 + 32 * kk + 8 * g);
#pragma unroll
      for (int i = 0; i < 4; ++i)
#pragma unroll
        for (int kk = 0; kk < 2; ++kk) *(LAS bf16x8*)(qlds + (i * 2 + kk) * 1024 + lane * 16) = qt[i][kk]; }
    const int c1 = 8 * (q >> 2) + (q & 3);
    const unsigned koff = (unsigned)(c1 * DM + 8 * g) * 2u, koff2 = koff + 4u * DM * 2u, voffL = (unsigned)(g * 512 + q * 8) * 2u, voffC = voffL;
    float addm[8]; int dcl[8];
#pragma unroll
    for (int e = 0; e < 8; ++e) { addm[e] = 0.f; dcl[e] = 0; }
    if (LOCAL) { const int qc = 16 * jb + q, ws = min(max(qc - 8, 0), 48), dc0 = bs + 8 * g - qc + 15;
#pragma unroll
        for (int e = 0; e < 8; ++e) { const int kc = bs + 8 * g + e; addm[e] = (kc >= ws && kc < ws + 16) ? 0.f : -3e38f; dcl[e] = min(max(dc0 + e, 0), 30); } }
    unsigned one2 = 0x3f803f80u; asm volatile("" : "+v"(one2));
    union { bf16x8 v; unsigned u[4]; } ones; ones.u[0] = ones.u[1] = ones.u[2] = ones.u[3] = one2;
    f32x4 osum[4];
#pragma unroll
    for (int i = 0; i < 4; ++i) osum[i] = (f32x4){0.f, 0.f, 0.f, 0.f};
    f32x4 o[4][4]; float mref[4];
#pragma unroll
    for (int i = 0; i < 4; ++i) { mref[i] = -1e30f;
#pragma unroll
        for (int mt = 0; mt < 4; ++mt) o[i][mt] = (f32x4){0.f, 0.f, 0.f, 0.f}; }
    bf16x8 kfc[4], kfn[4], vf[4];
#define ATTN_KBASE(G) ((const char*)(Kb + (size_t)((LOCAL && (G) < NL) ? (b * SEQ + (W0 + (G)) * 64 + bs) : (TL + b * CTXL + 32 * ((G) - NL))) * DM + h * 64))
#define ATTN_LOADK(dst, G) do { const char* kb_ = ATTN_KBASE(G); dst[0] = *(const bf16x8*)(kb_ + koff); dst[1] = *(const bf16x8*)(kb_ + koff + 64); dst[2] = *(const bf16x8*)(kb_ + koff2); dst[3] = *(const bf16x8*)(kb_ + koff2 + 64); } while (0)
    ATTN_LOADK(kfc, 0);
    unsigned dummy = 0;
    if (MODE == 2) { const char* vb0 = (const char*)(VtC + (size_t)(b * DM + h * 64) * CTXL);
#pragma unroll
        for (int mt = 0; mt < 4; ++mt) vf[mt] = *(const bf16x8*)(vb0 + voffC + (size_t)mt * 256); }
#pragma unroll 1
    for (int gi = 0; gi < NG; ++gi) {
        const bool locg = LOCAL && gi < NL;
        if (MODE != 2) { const char* vbase = locg ? (const char*)(VtL + (size_t)(b * DM + h * 64) * SEQ + ((W0 + gi) * 64 + bs) * 64) : (const char*)(VtC + (size_t)(b * DM + h * 64) * CTXL + 32 * (gi - NL) * 64);
          const unsigned vo = voffL; const size_t vst = 256;
#pragma unroll
          for (int mt = 0; mt < 4; ++mt) vf[mt] = *(const bf16x8*)(vbase + vo + mt * vst); }
        if (MODE != 2) { const int gn = gi + 1 < NG ? gi + 1 : gi; ATTN_LOADK(kfn, gn); }
        asm volatile("" ::: "memory");
        if (MODE == 1) {
#pragma unroll
            for (int k = 0; k < 4; ++k) { union { bf16x8 v; unsigned u[4]; } a, c; a.v = kfc[k]; c.v = vf[k]; dummy ^= (a.u[0] ^ a.u[1]) ^ (a.u[2] ^ a.u[3]) ^ (c.u[0] ^ c.u[1]) ^ (c.u[2] ^ c.u[3]); }
        }
#pragma unroll
        for (int i = 0; i < 4 && MODE != 1; ++i) {
            int drow = 0; bool act = true;
            if (locg) { const int r = R + i, r0 = min(max(r - 4, 0), 56), wr = W0 + gi; act = (wr >= r0) && (wr < r0 + 8); drow = wr - r + 7; }
            if (act) {
                const f32x4 z = (f32x4){0.f, 0.f, 0.f, 0.f};
                const bf16x8 q0_ = *(const LAS bf16x8*)(qlds + (i * 2) * 1024 + lane * 16), q1_ = *(const LAS bf16x8*)(qlds + (i * 2 + 1) * 1024 + lane * 16);
                f32x4 s0 = __builtin_amdgcn_mfma_f32_16x16x32_bf16(kfc[0], q0_, z, 0, 0, 0); s0 = __builtin_amdgcn_mfma_f32_16x16x32_bf16(kfc[1], q1_, s0, 0, 0, 0);
                f32x4 s1 = __builtin_amdgcn_mfma_f32_16x16x32_bf16(kfc[2], q0_, z, 0, 0, 0); s1 = __builtin_amdgcn_mfma_f32_16x16x32_bf16(kfc[3], q1_, s1, 0, 0, 0);
                float sv[8] = {s0[0], s0[1], s0[2], s0[3], s1[0], s1[1], s1[2], s1[3]};
                if (locg) { const LAS float* bp = bias + (h * 15 + drow) * 31;
#pragma unroll
                    for (int e = 0; e < 8; ++e) sv[e] = (sv[e] + bp[dcl[e]]) + addm[e]; }
                float lm = fmaxf(fmaxf(fmaxf(sv[0], sv[1]), fmaxf(sv[2], sv[3])), fmaxf(fmaxf(sv[4], sv[5]), fmaxf(sv[6], sv[7])));
                if (__any(lm > mref[i] + 40.0f)) {
                    lm = fmaxf(lm, __shfl_xor(lm, 16)); lm = fmaxf(lm, __shfl_xor(lm, 32)); const float mn = fmaxf(mref[i], lm), f = __builtin_amdgcn_exp2f(mref[i] - mn);
#pragma unroll
                    for (int mt = 0; mt < 4; ++mt) o[i][mt] = o[i][mt] * f;
                    osum[i] = osum[i] * f; mref[i] = mn; }
                float pv[8];
#pragma unroll
                for (int e = 0; e < 8; ++e) pv[e] = __builtin_amdgcn_exp2f(sv[e] - mref[i]);
                union { bf16x8 v; unsigned u[4]; } pf;
                pf.u[0] = pk2(pv[0], pv[1]); pf.u[1] = pk2(pv[2], pv[3]); pf.u[2] = pk2(pv[4], pv[5]); pf.u[3] = pk2(pv[6], pv[7]);
#pragma unroll
                for (int mt = 0; mt < 4; ++mt) o[i][mt] = __builtin_amdgcn_mfma_f32_16x16x32_bf16(vf[mt], pf.v, o[i][mt], 0, 0, 0);
                osum[i] = __builtin_amdgcn_mfma_f32_16x16x32_bf16(ones.v, pf.v, osum[i], 0, 0, 0);
            }
        }
        if (MODE != 2) {
#pragma unroll
            for (int k = 0; k < 4; ++k) kfc[k] = kfn[k]; }
    }
#undef ATTN_KBASE
#undef ATTN_LOADK
#pragma unroll
    for (int i = 0; i < 4; ++i) {
        const float inv = 1.0f / osum[i][0];
#pragma unroll
        for (int mt = 0; mt < 4; ++mt) { const f32x4 v = o[i][mt] * inv; u32x2 w; w.x = pk2(v[0], v[1]); w.y = pk2(v[2], v[3]);
            if (MODE == 0 || (w.x ^ dummy) == 0x12345u) *(u32x2*)(O + (size_t)(qtok[i] + q) * DM + h * 64 + 16 * mt + 4 * g) = w; }
    }
}
DEVFN void phase_attn(const Params& p, char* smem, int j, bool need_ctx) {
    const bf16_t* Q = (const bf16_t*)(p.BIG + NA_Q); const bf16_t* Kb = (const bf16_t*)(p.BIG + NA_K);
    const bf16_t* VtL = (const bf16_t*)(p.BIG + NA_VTL); const bf16_t* VtC = (const bf16_t*)(p.BIG + NA_VTC); bf16_t* O = (bf16_t*)(p.BIG + NA_O);
    const float* rpb = p.na_rpb + (size_t)j * 16 * 15 * 31;
    const int tid = TIDX, lane = tid & 63, wv = __builtin_amdgcn_readfirstlane(tid >> 6), gw = blockIdx.x * 8 + wv, NW = gridDim.x * 8;
    LAS float* bias = (LAS float*)smem; LAS unsigned char* qlds = (LAS unsigned char*)smem + 32768 + wv * 8192;
    __syncthreads();
    for (int i = tid; i < 16 * 15 * 31; i += NTHREADS) bias[i] = rpb[i] * 1.44269504f;
    __syncthreads();
    for (int u = gw; u < NB * 16 * 64; u += NW) { const int jb = u & 3, h = (u >> 2) & 15, bq = u >> 6; attn_unit<true>(Q, Kb, VtL, VtC, O, bias, qlds, bq >> 4, (bq & 15) * 4, h, jb, lane); }
    if (need_ctx) for (int u = gw; u < NB * 16 * 4; u += NW) { const int jb = u & 3, h = (u >> 2) & 15, b = u >> 6; attn_unit<false>(Q, Kb, VtL, VtC, O, bias, qlds, b, 0, h, jb, lane); }
#if ATTN_PROBE
    for (int u = gw; u < NB * 16 * 64; u += NW) { const int jb = u & 3, h = (u >> 2) & 15, bq = u >> 6; attn_unit<true, ATTN_PROBE>(Q, Kb, VtL, VtC, O, bias, qlds, bq >> 4, (bq & 15) * 4, h, jb, lane); }
#endif
    __syncthreads();
}

DEVFN void hy_gate_unit(const Params& p, char* smem, int R0, int t0, int L, int d0, bf16_t* vxt_row0  ) {
    bf16_t* tile = (bf16_t*)smem;
    const LAS float* wlds = (const LAS float*)(smem + 40960);
    const bf16_t* U = (const bf16_t*)(p.BIG + HY_U); bf16_t* X0 = (bf16_t*)(p.BIG + HY_X0);
    const int tid = TIDX, tt = tid >> 3, dd8 = tid & 7, t = t0 + tt;
    u32x4 uu[4][3][3];
#pragma unroll
    for (int j = 0; j < 3; ++j) { const int ts = t + j - 1; const bool ok = ts >= 0 && ts < L; const bf16_t* urow = U + (size_t)(R0 + tt + (ok ? j - 1 : 0)) * 3072 + d0 + 8 * dd8;
#pragma unroll
        for (int sub = 0; sub < 4; ++sub)
#pragma unroll
            for (int sec = 0; sec < 3; ++sec) { const u32x4 v = *(const u32x4*)(urow + sec * 1024 + 64 * sub); uu[sub][sec][j] = ok ? v : (u32x4){0u, 0u, 0u, 0u}; } }
#pragma unroll
    for (int sub = 0; sub < 4; ++sub) {
        const int dch = d0 + 64 * sub + 8 * dd8;
        float y[3][8];
#pragma unroll
        for (int sec = 0; sec < 3; ++sec) {
            const int c = sec * 1024 + dch;
            const f32x4 cb0 = *(const LAS f32x4*)(wlds + 3 * 3072 + c), cb1 = *(const LAS f32x4*)(wlds + 3 * 3072 + c + 4);
#pragma unroll
            for (int e = 0; e < 4; ++e) { y[sec][e] = cb0[e]; y[sec][4 + e] = cb1[e]; }
#pragma unroll
            for (int j = 0; j < 3; ++j) { const u32x4 u = uu[sub][sec][j];
                const f32x4 w0 = *(const LAS f32x4*)(wlds + j * 3072 + c), w1 = *(const LAS f32x4*)(wlds + j * 3072 + c + 4);
                y[sec][0] += w0[0] * bflo(u.x); y[sec][1] += w0[1] * bfhi(u.x); y[sec][2] += w0[2] * bflo(u.y); y[sec][3] += w0[3] * bfhi(u.y);
                y[sec][4] += w1[0] * bflo(u.z); y[sec][5] += w1[1] * bfhi(u.z); y[sec][6] += w1[2] * bflo(u.w); y[sec][7] += w1[3] * bfhi(u.w); }
        }
        { u32x4 w; w.x = pk2(y[0][0], y[0][1]); w.y = pk2(y[0][2], y[0][3]); w.z = pk2(y[0][4], y[0][5]); w.w = pk2(y[0][6], y[0][7]); *(u32x4*)(X0 + (size_t)(R0 + tt) * DM + dch) = w; }
#pragma unroll
        for (int e = 0; e < 8; e += 2) { const unsigned w = pk2(y[2][e] * y[1][e], y[2][e + 1] * y[1][e + 1]); tile[(64 * sub + 8 * dd8 + e) * 72 + tt] = (bf16_t)(w & 0xffff); tile[(64 * sub + 8 * dd8 + e + 1) * 72 + tt] = (bf16_t)(w >> 16); }
    }
    __syncthreads();
#pragma unroll
    for (int sub = 0; sub < 4; ++sub) { const int dd = 64 * sub + (tid >> 3), ts = tid & 7; const u32x4 w = *(const u32x4*)(tile + dd * 72 + 8 * ts); *(u32x4*)(vxt_row0 + (size_t)(d0 + dd) * L + t0 + 8 * ts) = w; }
    __syncthreads();
}
DEVFN void phase_hy_gate(const Params& p, char* smem) {
    { LAS float* wl = (LAS float*)(smem + 40960); const int tid = TIDX; __syncthreads();
      for (int i = tid; i < 3 * 768; i += NTHREADS) *(LAS f32x4*)(wl + 4 * i) = *(const f32x4*)(p.hy_conv_w + 4 * i);
      for (int i = tid; i < 768; i += NTHREADS) *(LAS f32x4*)(wl + 3 * 3072 + 4 * i) = *(const f32x4*)(p.hy_conv_b + 4 * i);
      __syncthreads(); }
    for (int u = blockIdx.x; u < 2048 + 128; u += gridDim.x) {
        if (u < 2048) { const int dt = u & 3, tt = (u >> 2) & 63, b = u >> 8; hy_gate_unit(p, smem, b * SEQ + tt * 64, tt * 64, SEQ, dt * 256, (bf16_t*)(p.BIG + HY_VXTL) + (size_t)b * DM * SEQ); }
        else { const int v = u - 2048, dt = v & 3, tt = (v >> 2) & 3, b = v >> 4; hy_gate_unit(p, smem, TL + b * CTXL + tt * 64, tt * 64, CTXL, dt * 256, (bf16_t*)(p.BIG + HY_VXTC) + (size_t)b * DM * CTXL); }
    }
}
template <int L>
DEVFN void hy_conv_unit(const Params& p, char* smem, int d) {
    constexpr int NI = (L >= NTHREADS) ? L / NTHREADS : 1;
    float* kk = (float*)smem;
    bf16_t* vs = (bf16_t*)(smem + 2 * L * 4);
    const float* ksrc = p.KC + (size_t)d * 2 * L;
    const bf16_t* vxt = (const bf16_t*)(p.BIG + (L == SEQ ? HY_VXTL : HY_VXTC)); bf16_t* yt = (bf16_t*)(p.BIG + (L == SEQ ? HY_YTL : HY_YTC));
    const int tid = TIDX;
    for (int i = tid; i < 2 * L; i += NTHREADS) kk[i] = ksrc[i];
    for (int i = tid; i < L; i += NTHREADS) { const int b = i / (L / 8), t8 = i % (L / 8);
        const u32x4 w = *(const u32x4*)(vxt + ((size_t)b * DM + d) * L + 8 * t8);
        bf16_t* dv = vs + (size_t)(8 * t8) * 8 + b;
        dv[0] = (bf16_t)(w.x & 0xffff); dv[8] = (bf16_t)(w.x >> 16); dv[16] = (bf16_t)(w.y & 0xffff); dv[24] = (bf16_t)(w.y >> 16);
        dv[32] = (bf16_t)(w.z & 0xffff); dv[40] = (bf16_t)(w.z >> 16); dv[48] = (bf16_t)(w.w & 0xffff); dv[56] = (bf16_t)(w.w >> 16); }
    __syncthreads();
    if (tid < L) {
        float acc[NI][8];
#pragma unroll
        for (int i = 0; i < NI; ++i)
#pragma unroll
            for (int b = 0; b < 8; ++b) acc[i][b] = 0.f;
        for (int s = 0; s < L; ++s) {
            const u32x4 w = *(const u32x4*)(vs + (size_t)s * 8);
            const float v0 = bflo(w.x), v1 = bfhi(w.x), v2 = bflo(w.y), v3 = bfhi(w.y), v4 = bflo(w.z), v5 = bfhi(w.z), v6 = bflo(w.w), v7 = bfhi(w.w);
#pragma unroll
            for (int i = 0; i < NI; ++i) { const float kv = kk[tid + NTHREADS * i - s + L];
                acc[i][0] += kv * v0; acc[i][1] += kv * v1; acc[i][2] += kv * v2; acc[i][3] += kv * v3; acc[i][4] += kv * v4; acc[i][5] += kv * v5; acc[i][6] += kv * v6; acc[i][7] += kv * v7; }
        }
#pragma unroll
        for (int i = 0; i < NI; ++i)
#pragma unroll
            for (int b = 0; b < 8; ++b) yt[((size_t)b * DM + d) * L + tid + NTHREADS * i] = (bf16_t)(pk2(acc[i][b], 0.f) & 0xffff);
    }
    __syncthreads();
}
DEVFN void hy_convmm_unit(const Params& p, char* smem, int d) {
    constexpr int VROW = 10000, ROFF = 8 * VROW;
    LAS unsigned char* lds = (LAS unsigned char*)smem;
    const int tid = TIDX;
    { const u32x4* src = (const u32x4*)(p.RK4 + (size_t)d * 4 * 8192);
#pragma unroll
      for (int i = 0; i < 8; ++i) { const int idx = tid + NTHREADS * i; *(LAS u32x4*)(lds + ROFF + idx * 16) = src[idx]; }
      const bf16_t* vxt = (const bf16_t*)(p.BIG + HY_VXTL);
#pragma unroll
      for (int i = 0; i < 8; ++i) { const int idx = tid + NTHREADS * i, b = idx >> 9, ch = idx & 511; *(LAS u32x4*)(lds + b * VROW + 896 + ch * 16) = *(const u32x4*)(vxt + ((size_t)b * DM + d) * SEQ + 8 * ch); }
      for (int idx = tid; idx < 896; idx += NTHREADS) { const int b = idx / 112, k = idx % 112; *(LAS u32x4*)(lds + b * VROW + (k < 56 ? k * 16 : 896 + 8192 + (k - 56) * 16)) = (u32x4){0u, 0u, 0u, 0u}; } }
    __syncthreads();
    const int lane = tid & 63, w = __builtin_amdgcn_readfirstlane(tid >> 6), fr = lane & 15, fq = lane >> 4, sg = (3 - fr) & 3;
    const unsigned abase = (unsigned)(ROFF + sg * 16384 + (3647 - 512 * w - fr + 8 * fq - sg) * 2 - 96);
    const unsigned vbase = (unsigned)((fr & 7) * VROW + (64 * (fr >> 3) + 8 * fq) * 2);
    f32x4 acc[4][4];
#pragma unroll
    for (int it = 0; it < 4; ++it)
#pragma unroll
        for (int nt = 0; nt < 4; ++nt) acc[it][nt] = (f32x4){0.f, 0.f, 0.f, 0.f};
#pragma unroll 2
    for (int mm = 0; mm < 71; ++mm) {
        union { bf16x8 v; u32x2 h[2]; } af[6];
#pragma unroll
        for (int k = 0; k < 6; ++k) { const LAS unsigned char* a = lds + abase + mm * 128 + 160 - 32 * k; af[k].h[0] = *(const LAS u32x2*)a; af[k].h[1] = *(const LAS u32x2*)(a + 8); }
        bf16x8 bf[4][2];
#pragma unroll
        for (int nt = 0; nt < 4; ++nt)
#pragma unroll
            for (int jh = 0; jh < 2; ++jh) bf[nt][jh] = *(const LAS bf16x8*)(lds + vbase + mm * 128 + 256 * nt + 64 * jh);
#pragma unroll
        for (int jh = 0; jh < 2; ++jh)
#pragma unroll
            for (int it = 0; it < 4; ++it)
#pragma unroll
                for (int nt = 0; nt < 4; ++nt) acc[it][nt] = __builtin_amdgcn_mfma_f32_16x16x32_bf16(af[it - 2 * jh + 2].v, bf[nt][jh], acc[it][nt], 0, 0, 0);
    }
    bf16_t* yt = (bf16_t*)(p.BIG + HY_YTL) + ((size_t)(fr & 7) * DM + d) * SEQ;
#pragma unroll
    for (int it = 0; it < 4; ++it)
#pragma unroll
        for (int nt = 0; nt < 4; ++nt) { const int a = 8 * w + 2 * nt + (fr >> 3); u32x2 o; o.x = pk2(acc[it][nt][0], acc[it][nt][1]); o.y = pk2(acc[it][nt][2], acc[it][nt][3]);
            *(u32x2*)(yt + 64 * a + 16 * it + 4 * fq) = o; }
    __syncthreads();
}
DEVFN void hy_post_unit(const Params& p, char* smem, int R0, int t0, int L, int d0, const bf16_t* yt0, const bf16_t* vxt0) {
    bf16_t* tile = (bf16_t*)smem;
    const bf16_t* X0 = (const bf16_t*)(p.BIG + HY_X0); bf16_t* YB = (bf16_t*)(p.BIG + HY_YB);
    const int tid = TIDX;
    { const int ts = tid & 7; u32x4 a[4], v[4];
#pragma unroll
      for (int sub = 0; sub < 4; ++sub) { const int dd = 64 * sub + (tid >> 3); const size_t o = (size_t)(d0 + dd) * L + t0 + 8 * ts; a[sub] = *(const u32x4*)(yt0 + o); v[sub] = *(const u32x4*)(vxt0 + o); }
#pragma unroll
      for (int sub = 0; sub < 4; ++sub) { const int dd = 64 * sub + (tid >> 3); const float sk = p.hy_skip[d0 + dd];
        u32x4 w; w.x = pk2(bflo(a[sub].x) + bflo(v[sub].x) * sk, bfhi(a[sub].x) + bfhi(v[sub].x) * sk); w.y = pk2(bflo(a[sub].y) + bflo(v[sub].y) * sk, bfhi(a[sub].y) + bfhi(v[sub].y) * sk);
        w.z = pk2(bflo(a[sub].z) + bflo(v[sub].z) * sk, bfhi(a[sub].z) + bfhi(v[sub].z) * sk); w.w = pk2(bflo(a[sub].w) + bflo(v[sub].w) * sk, bfhi(a[sub].w) + bfhi(v[sub].w) * sk);
        *(u32x4*)(tile + dd * 72 + 8 * ts) = w; } }
    __syncthreads();
    { const int tt = tid >> 3, dd8 = tid & 7; u32x4 x0[4];
#pragma unroll
      for (int sub = 0; sub < 4; ++sub) x0[sub] = *(const u32x4*)(X0 + (size_t)(R0 + tt) * DM + d0 + 64 * sub + 8 * dd8);
#pragma unroll
      for (int sub = 0; sub < 4; ++sub) { float z[8];
#pragma unroll
        for (int e = 0; e < 8; ++e) z[e] = bf2f(tile[(64 * sub + 8 * dd8 + e) * 72 + tt]);
        u32x4 w; w.x = pk2(z[0] * bflo(x0[sub].x), z[1] * bfhi(x0[sub].x)); w.y = pk2(z[2] * bflo(x0[sub].y), z[3] * bfhi(x0[sub].y)); w.z = pk2(z[4] * bflo(x0[sub].z), z[5] * bfhi(x0[sub].z)); w.w = pk2(z[6] * bflo(x0[sub].w), z[7] * bfhi(x0[sub].w));
        *(u32x4*)(YB + (size_t)(R0 + tt) * DM + d0 + 64 * sub + 8 * dd8) = w; } }
    __syncthreads();
}
DEVFN void phase_hy_post(const Params& p, char* smem) {
    for (int u = blockIdx.x; u < 2048 + 128; u += gridDim.x) {
        if (u < 2048) { const int dt = u & 3, tt = (u >> 2) & 63, b = u >> 8; hy_post_unit(p, smem, b * SEQ + tt * 64, tt * 64, SEQ, dt * 256, (const bf16_t*)(p.BIG + HY_YTL) + (size_t)b * DM * SEQ, (const bf16_t*)(p.BIG + HY_VXTL) + (size_t)b * DM * SEQ); }
        else { const int v = u - 2048, dt = v & 3, tt = (v >> 2) & 3, b = v >> 4; hy_post_unit(p, smem, TL + b * CTXL + tt * 64, tt * 64, CTXL, dt * 256, (const bf16_t*)(p.BIG + HY_YTC) + (size_t)b * DM * CTXL, (const bf16_t*)(p.BIG + HY_VXTC) + (size_t)b * DM * CTXL); }
    }
}

DEVFN void gm_sp_unit(const Params& p, char* smem, int ck, int g) {
    constexpr int PROW = 272;
    LAS unsigned char* lds = (LAS unsigned char*)smem;
    LAS float* mu = (LAS float*)(lds + 192 * PROW);
    LAS float* rs = mu + 128;
    const bf16_t* ZU = (const bf16_t*)(p.BIG + GM_Z); const bf16_t* VT = (const bf16_t*)(p.BIG + GM_VT); bf16_t* UV = (bf16_t*)(p.BIG + GM_UV);
    const int tid = TIDX, lane = tid & 63, w = __builtin_amdgcn_readfirstlane(tid >> 6), fr = lane & 15, fq = lane >> 4;
    { const bf16_t* src = VT + ((size_t)ck * 3072 + g * 192) * 128;
#pragma unroll
      for (int i = 0; i < 6; ++i) { const int idx = tid + NTHREADS * i, c = idx >> 4, ch = idx & 15, w5 = c & 31, slot = (c & ~31) + 16 * ((w5 >> 2) & 1) + 4 * (w5 >> 3) + (w5 & 3);
          *(LAS u32x4*)(lds + slot * PROW + ch * 16) = *(const u32x4*)(src + (size_t)c * 128 + ch * 8); }
      if (tid < 128) { const f32x4* sp = (const f32x4*)(p.STAT + (size_t)(ck * 128 + tid) * 48); float sx = 0.f, sy = 0.f;
#pragma unroll
          for (int k = 0; k < 12; ++k) { const f32x4 v = sp[k]; sx += v[0]; sy += v[1]; sx += v[2]; sy += v[3]; }
          const float mean = sx * (1.0f / 3072.0f), var = fmaxf(sy * (1.0f / 3072.0f) - mean * mean, 0.f);
          mu[tid] = mean; rs[tid] = rsqrtf(var + 1e-6f); } }
    __syncthreads();
    bf16x8 af[4], mf[4];
    { const bf16_t* ap = p.GMWS + (size_t)(g * 128 + 16 * w + fr) * 128 + 8 * fq;
#pragma unroll
      for (int kk = 0; kk < 4; ++kk) { const u32x4 a = *(const u32x4*)(ap + 32 * kk); const int q0 = 32 * kk + 8 * fq;
          const f32x4 r0 = *(const LAS f32x4*)(rs + q0), r1 = *(const LAS f32x4*)(rs + q0 + 4), m0 = *(const LAS f32x4*)(mu + q0), m1 = *(const LAS f32x4*)(mu + q0 + 4);
          union { bf16x8 v; u32x4 u; } x, y;
          x.u = (u32x4){pk2(bflo(a.x) * r0[0], bfhi(a.x) * r0[1]), pk2(bflo(a.y) * r0[2], bfhi(a.y) * r0[3]), pk2(bflo(a.z) * r1[0], bfhi(a.z) * r1[1]), pk2(bflo(a.w) * r1[2], bfhi(a.w) * r1[3])};
          y.u = pack8(m0, m1); af[kk] = x.v; mf[kk] = y.v; } }
    f32x4 acc[12], acc1 = (f32x4){0.f, 0.f, 0.f, 0.f};
#pragma unroll
    for (int nt = 0; nt < 12; ++nt) acc[nt] = (f32x4){0.f, 0.f, 0.f, 0.f};
#pragma unroll
    for (int kk = 0; kk < 4; ++kk) {
        acc1 = __builtin_amdgcn_mfma_f32_16x16x32_bf16(mf[kk], af[kk], acc1, 0, 0, 0);
#pragma unroll
        for (int nt = 0; nt < 12; ++nt) { const bf16x8 bf = *(const LAS bf16x8*)(lds + (16 * nt + fr) * PROW + (32 * kk + 8 * fq) * 2); acc[nt] = __builtin_amdgcn_mfma_f32_16x16x32_bf16(bf, af[kk], acc[nt], 0, 0, 0); } }
    const int prow = 16 * w + fr, row = ck * 128 + prow; const float bsv = p.gm_b_s[g * 128 + prow], s0 = p.GMS0[g * 128 + prow], s1 = acc1[0];
#pragma unroll
    for (int np = 0; np < 6; ++np) { const int col = g * 192 + 32 * np + 8 * fq; const u32x4 uu = *(const u32x4*)(ZU + (size_t)row * 3072 + col);
        const f32x4 lg0 = *(const f32x4*)(p.gm_ln_g + col), lg1 = *(const f32x4*)(p.gm_ln_g + col + 4), lb0 = *(const f32x4*)(p.gm_ln_b + col), lb1 = *(const f32x4*)(p.gm_ln_b + col + 4);
        const f32x4 o0 = (lg0 * (acc[2 * np] - s1) + lb0 * s0 + bsv) * (f32x4){bflo(uu.x), bfhi(uu.x), bflo(uu.y), bfhi(uu.y)};
        const f32x4 o1 = (lg1 * (acc[2 * np + 1] - s1) + lb1 * s0 + bsv) * (f32x4){bflo(uu.z), bfhi(uu.z), bflo(uu.w), bfhi(uu.w)};
        *(u32x4*)(UV + (size_t)row * 3072 + col) = pack8(o0, o1); }
    __syncthreads();
}

DEVFN void phase_n2_route(const Params& p, char* smem, int layer, int ntok, int dry) {
    constexpr int WROW = 2064, WLO = 32 * WROW, GSOFF = 2 * WLO, MISC = GSOFF + 16384;
    LAS unsigned char* lds = (LAS unsigned char*)smem;
    LAS float* GS = (LAS float*)(lds + GSOFF);
    int* lcnt = (int*)(smem + MISC);
    int* gbase = lcnt + 32;
    int* ent = gbase + 32;
    const int tid = TIDX, lane = tid & 63, wave = __builtin_amdgcn_readfirstlane(tid >> 6), t = lane & 15, g = lane >> 4;
    const int CT = ntok / 256, PW = CT >> 3;
    if (layer >= 1) conv_drain(p, smem, layer);
    const float* rw = p.moe_router_w + (size_t)layer * 1024 * 32;
    for (int idx = tid; idx < 8192; idx += NTHREADS) { const f32x4 v = *(const f32x4*)(rw + 4 * idx); const int c = idx >> 3, e0 = (idx & 7) * 4;
#pragma unroll
        for (int jj = 0; jj < 4; ++jj) { const unsigned hi = pk2(v[jj], 0.f) & 0xffffu; const float lo = v[jj] - __uint_as_float(hi << 16);
            *(LAS bf16_t*)(lds + (e0 + jj) * WROW + c * 2) = (bf16_t)hi; *(LAS bf16_t*)(lds + WLO + (e0 + jj) * WROW + c * 2) = (bf16_t)(pk2(lo, 0.f) & 0xffffu); } }
    const float rb0 = p.moe_router_b[layer * 32 + t], rb1 = p.moe_router_b[layer * 32 + 16 + t];
    const float* g2n = p.norm2_g + layer * 1024;
    for (int chunk = blockIdx.x; chunk < 256; chunk += gridDim.x) {
        const int tokc0 = chunk * CT, tokc1 = tokc0 + CT - 1, mrA = tokc0 < TL ? (tokc0 >> 12) : 8, mrB = tokc1 < TL ? (tokc1 >> 12) : 8;
        __syncthreads();
        if (tid < 32) lcnt[tid] = 0;
        for (int idx = tid; idx < 2048; idx += NTHREADS) { const int sl = idx >> 10, c = idx & 1023; const float* mod = p.MOD + ((size_t)layer * 9 + (sl ? mrB : mrA)) * 6144;
            GS[sl * 2048 + c] = g2n[c] * (mod[4 * 1024 + c] + 1.0f); GS[sl * 2048 + 1024 + c] = mod[3 * 1024 + c]; }
        __syncthreads();
        {
            const bool hasB = PW > 16;
            const int tl0 = wave * PW;
            const int tok = tokc0 + tl0 + t, mr = tok < TL ? (tok >> 12) : 8;
            const int tokB = tokc0 + tl0 + (hasB ? 16 : 15), mrB = tokB < TL ? (tokB >> 12) : 8;
            const LAS float* Gt = GS + (mr == mrA ? 0 : 2048);
            const LAS float* GtB = GS + (mrB == mrA ? 0 : 2048);
            const bool sameG = __all(mr == mrB) != 0;
            const bf16_t* xrow = p.X + (size_t)tok * DM + 8 * g;
            const bf16_t* xrowB = p.X + (size_t)tokB * DM + 8 * g;
            float ss = 0.f, ssB = 0.f;
            { u32x4 xs[32];
              u32x4 xb0 = (u32x4){0u, 0u, 0u, 0u}, xb1 = xb0;
#pragma unroll
              for (int s = 0; s < 32; ++s) xs[s] = *(const u32x4*)(xrow + 32 * s);
              if (hasB) { xb0 = *(const u32x4*)(xrowB + 32 * t); xb1 = *(const u32x4*)(xrowB + 32 * (t + 16)); }
              asm volatile("" ::: "memory");
#pragma unroll
              for (int s = 0; s < 32; ++s) { const u32x4 xv = xs[s];
                const float a0 = bflo(xv.x), a1 = bfhi(xv.x), a2 = bflo(xv.y), a3 = bfhi(xv.y), a4 = bflo(xv.z), a5 = bfhi(xv.z), a6 = bflo(xv.w), a7 = bfhi(xv.w);
                ss += ((a0 * a0 + a1 * a1) + (a2 * a2 + a3 * a3)) + ((a4 * a4 + a5 * a5) + (a6 * a6 + a7 * a7)); }
#pragma unroll
              for (int hh = 0; hh < 2; ++hh) { const u32x4 xv = hh ? xb1 : xb0;
                const float a0 = bflo(xv.x), a1 = bfhi(xv.x), a2 = bflo(xv.y), a3 = bfhi(xv.y), a4 = bflo(xv.z), a5 = bfhi(xv.z), a6 = bflo(xv.w), a7 = bfhi(xv.w);
                ssB += ((a0 * a0 + a1 * a1) + (a2 * a2 + a3 * a3)) + ((a4 * a4 + a5 * a5) + (a6 * a6 + a7 * a7)); } }
            ss += __shfl_xor(ss, 16); ss += __shfl_xor(ss, 32);
            ssB = wave_sum(ssB);
            const float r = rsqrtf(ss * (1.0f / DM) + 1e-6f), rB = rsqrtf(ssB * (1.0f / DM) + 1e-6f);
            f32x4 acc0 = (f32x4){0.f, 0.f, 0.f, 0.f}, acc1 = acc0, accB0 = acc0, accB1 = acc0;
            bf16_t* hrow = p.HX + (size_t)tok * DM + 8 * g;
            bf16_t* hrowB = p.HX + (size_t)tokB * DM + 8 * g;
#pragma unroll 4
            for (int s = 0; s < 32; ++s) {
                const int c0 = 32 * s + 8 * g; const u32x4 xv = *(const u32x4*)(xrow + 32 * s);
                u32x4 xvB = (u32x4){0u, 0u, 0u, 0u}; if (hasB) xvB = *(const u32x4*)(xrowB + 32 * s);
                const LAS unsigned char* wp = lds + t * WROW + c0 * 2;
                const bf16x8 wh0 = *(const LAS bf16x8*)(wp), wh1 = *(const LAS bf16x8*)(wp + 16 * WROW), wl0 = *(const LAS bf16x8*)(wp + WLO), wl1 = *(const LAS bf16x8*)(wp + WLO + 16 * WROW);
                const f32x4 G0 = *(const LAS f32x4*)(Gt + c0), G1 = *(const LAS f32x4*)(Gt + c0 + 4), S0 = *(const LAS f32x4*)(Gt + 1024 + c0), S1 = *(const LAS f32x4*)(Gt + 1024 + c0 + 4);
                { const f32x4 x0 = (f32x4){bflo(xv.x), bfhi(xv.x), bflo(xv.y), bfhi(xv.y)}, x1 = (f32x4){bflo(xv.z), bfhi(xv.z), bflo(xv.w), bfhi(xv.w)};
                  const f32x4 h0 = (x0 * r) * G0 + S0, h1 = (x1 * r) * G1 + S1;
                  union { bf16x8 v; u32x4 u; } hi, lo;
                  hi.u = pack8(h0, h1);
                  if (!dry || hi.u.x == 0x12345u) *(u32x4*)(hrow + 32 * s) = hi.u;
                  const f32x4 l0 = h0 - (f32x4){bflo(hi.u.x), bfhi(hi.u.x), bflo(hi.u.y), bfhi(hi.u.y)}, l1 = h1 - (f32x4){bflo(hi.u.z), bfhi(hi.u.z), bflo(hi.u.w), bfhi(hi.u.w)};
                  lo.u = pack8(l0, l1);
                  acc0 = __builtin_amdgcn_mfma_f32_16x16x32_bf16(hi.v, wh0, acc0, 0, 0, 0); acc0 = __builtin_amdgcn_mfma_f32_16x16x32_bf16(lo.v, wh0, acc0, 0, 0, 0); acc0 = __builtin_amdgcn_mfma_f32_16x16x32_bf16(hi.v, wl0, acc0, 0, 0, 0);
                  acc1 = __builtin_amdgcn_mfma_f32_16x16x32_bf16(hi.v, wh1, acc1, 0, 0, 0); acc1 = __builtin_amdgcn_mfma_f32_16x16x32_bf16(lo.v, wh1, acc1, 0, 0, 0); acc1 = __builtin_amdgcn_mfma_f32_16x16x32_bf16(hi.v, wl1, acc1, 0, 0, 0); }
                if (hasB) {
                  f32x4 G0b = G0, G1b = G1, S0b = S0, S1b = S1;
                  if (!sameG) { G0b = *(const LAS f32x4*)(GtB + c0); G1b = *(const LAS f32x4*)(GtB + c0 + 4); S0b = *(const LAS f32x4*)(GtB + 1024 + c0); S1b = *(const LAS f32x4*)(GtB + 1024 + c0 + 4); }
                  const f32x4 x0 = (f32x4){bflo(xvB.x), bfhi(xvB.x), bflo(xvB.y), bfhi(xvB.y)}, x1 = (f32x4){bflo(xvB.z), bfhi(xvB.z), bflo(xvB.w), bfhi(xvB.w)};
                  const f32x4 h0 = (x0 * rB) * G0b + S0b, h1 = (x1 * rB) * G1b + S1b;
                  union { bf16x8 v; u32x4 u; } hi, lo;
                  hi.u = pack8(h0, h1);
                  if (t == 0 && (!dry || hi.u.x == 0x12345u)) *(u32x4*)(hrowB + 32 * s) = hi.u;
                  const f32x4 l0 = h0 - (f32x4){bflo(hi.u.x), bfhi(hi.u.x), bflo(hi.u.y), bfhi(hi.u.y)}, l1 = h1 - (f32x4){bflo(hi.u.z), bfhi(hi.u.z), bflo(hi.u.w), bfhi(hi.u.w)};
                  lo.u = pack8(l0, l1);
                  accB0 = __builtin_amdgcn_mfma_f32_16x16x32_bf16(hi.v, wh0, accB0, 0, 0, 0); accB0 = __builtin_amdgcn_mfma_f32_16x16x32_bf16(lo.v, wh0, accB0, 0, 0, 0); accB0 = __builtin_amdgcn_mfma_f32_16x16x32_bf16(hi.v, wl0, accB0, 0, 0, 0);
                  accB1 = __builtin_amdgcn_mfma_f32_16x16x32_bf16(hi.v, wh1, accB1, 0, 0, 0); accB1 = __builtin_amdgcn_mfma_f32_16x16x32_bf16(lo.v, wh1, accB1, 0, 0, 0); accB1 = __builtin_amdgcn_mfma_f32_16x16x32_bf16(hi.v, wl1, accB1, 0, 0, 0); }
            }
#pragma unroll 1
            for (int pass = 0; pass < (hasB ? 2 : 1); ++pass) {
                const int tlb = pass ? tl0 + 16 : tl0, ntile = pass ? 1 : 16;
                float v0[4], v1[4]; float tv[4][4]; int te[4][4];
#pragma unroll
                for (int j = 0; j < 4; ++j) { v0[j] = (pass ? accB0[j] : acc0[j]) + rb0; v1[j] = (pass ? accB1[j] : acc1[j]) + rb1; }
#pragma unroll
                for (int k = 0; k < 4; ++k)
#pragma unroll
                    for (int j = 0; j < 4; ++j) { float m = fmaxf(v0[j], v1[j]);
                        m = fmaxf(m, __shfl_xor(m, 1)); m = fmaxf(m, __shfl_xor(m, 2)); m = fmaxf(m, __shfl_xor(m, 4)); m = fmaxf(m, __shfl_xor(m, 8));
                        int cand = (v0[j] == m) ? t : ((v1[j] == m) ? 16 + t : 99);
                        cand = min(cand, __shfl_xor(cand, 1)); cand = min(cand, __shfl_xor(cand, 2)); cand = min(cand, __shfl_xor(cand, 4)); cand = min(cand, __shfl_xor(cand, 8));
                        cand &= 31; tv[j][k] = m; te[j][k] = cand; if (cand == t) v0[j] = -INFINITY; if (cand == 16 + t) v1[j] = -INFINITY; }
                if (t == 0) {
#pragma unroll
                    for (int j = 0; j < 4; ++j) { const int tt = 4 * g + j;
                        if (tt < ntile) { const float e1 = __expf(tv[j][1] - tv[j][0]), e2 = __expf(tv[j][2] - tv[j][0]), e3 = __expf(tv[j][3] - tv[j][0]), rinv = 1.0f / (1.0f + e1 + e2 + e3);
                            const float gt[4] = {rinv, e1 * rinv, e2 * rinv, e3 * rinv}; const int tl = tlb + tt;
#pragma unroll
                            for (int k = 0; k < 4; ++k) { const int lp = atomicAdd(&lcnt[te[j][k]], 1); ent[(tl * 4 + k) * 3] = te[j][k]; ent[(tl * 4 + k) * 3 + 1] = lp; ent[(tl * 4 + k) * 3 + 2] = __float_as_int(gt[k]); } } }
                }
            }
        }
        __syncthreads();
        if (tid < 32) gbase[tid] = dry ? 0 : __hip_atomic_fetch_add(p.cnt + layer * 32 + tid, lcnt[tid], __ATOMIC_RELAXED, __HIP_MEMORY_SCOPE_AGENT);
        __syncthreads();
        for (int idx = tid; idx < CT * 4; idx += NTHREADS) { const int e = ent[idx * 3], pos = gbase[e] + ent[idx * 3 + 1]; const int tok = chunk * CT + (idx >> 2);
            if (!dry || pos == 0x7fffffff) { p.toklist[(size_t)e * TT + pos] = tok; p.gatelist[(size_t)e * TT + pos] = __int_as_float(ent[idx * 3 + 2]); p.assign[(size_t)tok * 4 + (idx & 3)] = (e << 20) | pos; } }
    }
    __syncthreads();
}
DEVFN int moe_tables(const Params& p, char* smem, int layer) {
    int* tstart = (int*)(smem + SMEM_GEMM); int* ecnt = tstart + 64;
    __syncthreads();
    if (TIDX < 64) { const int lane = TIDX; const int c = lane < 32 ? __hip_atomic_load(p.cnt + layer * 32 + lane, __ATOMIC_RELAXED, __HIP_MEMORY_SCOPE_AGENT) : 0; const int nt = (c + 255) >> 8; int inc = nt;
#pragma unroll
        for (int o = 1; o < 32; o <<= 1) { const int t = __shfl_up(inc, o); if ((lane & 31) >= o) inc += t; }
        if (lane < 32) { tstart[lane + 1] = inc; ecnt[lane] = c; if (lane == 0) tstart[0] = 0; } }
    __syncthreads();
    return tstart[32];
}
template <int NP> DEVFN bool moe_unit(int ui, int R, int& rt, int& pn) {
    constexpr int RPX = 32 / NP; const int b = blockIdx.x, x = b & 7, j = (b >> 3) & 31, g32 = b >> 8;
    const int rounds_per = (gridDim.x + 255) >> 8;
    rt = ((ui * rounds_per + g32) * 8 + x) * RPX + j / NP; pn = j % NP; return rt < R;
}
struct ProvMoe1 {
    const Params* p; const int* tstart; const int* ecnt; int layer, R, dry;
    DEVFN bool next(int ui, const char*& A, const char*& B, unsigned (&va)[2][2], EpiSwiglu& epi) const {
        int rt, pn; if (!moe_unit<8>(ui, R, rt, pn)) return false;
        int e = 0;
#pragma unroll 1
        for (int k = 16; k >= 1; k >>= 1) if (tstart[e + k] <= rt) e += k;
        const int rb = rt - tstart[e], cnt = ecnt[e];
#pragma unroll
        for (int i = 0; i < 2; ++i) { int r, c; stage_rc(TIDX * 16 + i * 8192, r, c);
#pragma unroll
            for (int hh = 0; hh < 2; ++hh) { const int pos = min(rb * 256 + hh * 128 + r, cnt - 1); const int tok = p->toklist[(size_t)e * TT + pos]; va[hh][i] = ((unsigned)tok * DM + c) * 2u; } }
        A = (const char*)p->HX; B = (const char*)(p->MOEGU + ((size_t)layer * 32 + e) * 2048 * 1024 + (size_t)pn * 256 * DM);
        epi = EpiSwiglu{p->ACT, rt * 256, pn * 128, p->moe_b_gu + ((size_t)layer * 32 + e) * 2048, dry};
        return true;
    }
};
struct ProvMoe2 {
    const Params* p; const int* tstart; const int* ecnt; int layer, R, dry;
    DEVFN bool next(int ui, const char*& A, const char*& B, unsigned (&va)[2][2], EpiMoeDn& epi) const {
        int rt, pn; if (!moe_unit<4>(ui, R, rt, pn)) return false;
        int e = 0;
#pragma unroll 1
        for (int k = 16; k >= 1; k >>= 1) if (tstart[e + k] <= rt) e += k;
        const int rb = rt - tstart[e], cnt = ecnt[e];
        A = (const char*)(p->ACT + (size_t)rt * 256 * DM); B = (const char*)(p->MOEDN + ((size_t)layer * 32 + e) * 1024 * 1024 + (size_t)pn * 256 * DM);
        epi = EpiMoeDn{p->OUTS, rt * 256, pn * 256, p->moe_b_dn + ((size_t)layer * 32 + e) * 1024, p->gatelist + (size_t)e * TT, cnt, rb, dry};
        return true;
    }
};
DEVFN void phase_moe1(const Params& p, char* smem, int layer, int dry) {
    const int R = moe_tables(p, smem, layer); const int* tstart = (const int*)(smem + SMEM_GEMM); const int* ecnt = tstart + 64;
    int rt, pn, ui = 0;
    for (; moe_unit<8>(ui, R, rt, pn); ++ui) {
        int e = 0;
#pragma unroll 1
        for (int k = 16; k >= 1; k >>= 1) if (tstart[e + k] <= rt) e += k;
        const int rb = rt - tstart[e], cnt = ecnt[e];
        unsigned va[2][2], vb[2];
#pragma unroll
        for (int i = 0; i < 2; ++i) { int r, c; stage_rc(TIDX * 16 + i * 8192, r, c);
#pragma unroll
            for (int hh = 0; hh < 2; ++hh) { const int pos = min(rb * 256 + hh * 128 + r, cnt - 1); const int tok = p.toklist[(size_t)e * TT + pos]; va[hh][i] = ((unsigned)tok * DM + c) * 2u; } }
        lin_voff_b(vb, DM);
        const char* W = (const char*)(p.MOEGU + ((size_t)layer * 32 + e) * 2048 * 1024 + (size_t)pn * 256 * DM);
        EpiSwiglu epi{p.ACT, rt * 256, pn * 128, p.moe_b_gu + ((size_t)layer * 32 + e) * 2048, dry};
        gemm_tile<true>(smem, (const char*)p.HX, (const char*)p.HX, va, W, W + (size_t)HALF * DM * 2, vb, DM / BK, epi);
    }
    if (ui < ((R + 31) >> 5) * ((gridDim.x + 255) >> 8)) conv_fill(p, smem, layer + 1, FILL_MOE);
}
DEVFN void phase_moe2(const Params& p, char* smem, int layer, int dry) {
    const int R = moe_tables(p, smem, layer); const int* tstart = (const int*)(smem + SMEM_GEMM); const int* ecnt = tstart + 64;
    int rt, pn, ui = 0;
    for (; moe_unit<4>(ui, R, rt, pn); ++ui) {
        int e = 0;
#pragma unroll 1
        for (int k = 16; k >= 1; k >>= 1) if (tstart[e + k] <= rt) e += k;
        const int rb = rt - tstart[e], cnt = ecnt[e];
        unsigned va[2][2], vb[2], vt[2]; lin_voff(vt, DM); lin_voff_b(vb, DM); va[0][0] = va[1][0] = vt[0]; va[0][1] = va[1][1] = vt[1];
        const char* A = (const char*)(p.ACT + (size_t)rt * 256 * DM); const char* W = (const char*)(p.MOEDN + ((size_t)layer * 32 + e) * 1024 * 1024 + (size_t)pn * 256 * DM);
        EpiMoeDn epi{p.OUTS, rt * 256, pn * 256, p.moe_b_dn + ((size_t)layer * 32 + e) * 1024, p.gatelist + (size_t)e * TT, cnt, rb, dry};
        gemm_tile<true>(smem, A, A + (size_t)HALF * DM * 2, va, W, W + (size_t)HALF * DM * 2, vb, DM / BK, epi);
    }
    if (ui < ((R + 63) >> 6) * ((gridDim.x + 255) >> 8)) conv_fill(p, smem, layer + 1, FILL_MOE);
}
DEVFN void phase_combine(const Params& p, int layer, bool last, int dry) {
    const int lane = TIDX & 63, gw = blockIdx.x * 8 + (TIDX >> 6), NW = gridDim.x * 8, ntok = last ? TL : TT;
    int tst;
    { const int c = lane < 32 ? __hip_atomic_load(p.cnt + layer * 32 + lane, __ATOMIC_RELAXED, __HIP_MEMORY_SCOPE_AGENT) : 0; const int nt = (c + 255) >> 8; int inc = nt;
#pragma unroll
        for (int o = 1; o < 32; o <<= 1) { const int t = __shfl_up(inc, o); if ((lane & 31) >= o) inc += t; }
        tst = inc - nt; }
    const int per = (ntok + NW - 1) / NW, tok0 = gw * per, cnt = min(per, ntok - tok0);
    if (cnt <= 0) return;
    int myslot[4];
    { int a[4];
#pragma unroll
      for (int k = 0; k < 4; ++k) a[k] = lane < cnt ? p.assign[(size_t)(tok0 + lane) * 4 + k] : 0;
#pragma unroll
      for (int k = 0; k < 4; ++k) myslot[k] = 256 * __shfl(tst, (a[k] >> 20) & 31) + (a[k] & 0xfffff); }
    int cur_mr = -1; f32x4 G2[4], GN[4], SH[4];
#pragma unroll
    for (int i = 0; i < 4; ++i) { G2[i] = (f32x4){0.f, 0.f, 0.f, 0.f}; GN[i] = G2[i]; SH[i] = G2[i]; }
#pragma unroll 1
    for (int ti = 0; ti < cnt; ti += 2) {
        const bool hasB = ti + 1 < cnt; const int tokA = tok0 + ti, tokB = hasB ? tokA + 1 : tokA;
        int sA[4], sB[4];
#pragma unroll
        for (int k = 0; k < 4; ++k) { sA[k] = __shfl(myslot[k], ti); sB[k] = __shfl(myslot[k], hasB ? ti + 1 : ti); }
        u32x2 xa[4], xb[4]; u32x2 oa[4][4], ob[4][4];
#pragma unroll
        for (int i = 0; i < 4; ++i) { const int c = 4 * lane + 256 * i; xa[i] = *(const u32x2*)(p.X + (size_t)tokA * DM + c);
#pragma unroll
            for (int k = 0; k < 4; ++k) oa[i][k] = *(const u32x2*)(p.OUTS + (size_t)sA[k] * DM + c); }
#pragma unroll
        for (int i = 0; i < 4; ++i) { const int c = 4 * lane + 256 * i; xb[i] = *(const u32x2*)(p.X + (size_t)tokB * DM + c);
#pragma unroll
            for (int k = 0; k < 4; ++k) ob[i][k] = *(const u32x2*)(p.OUTS + (size_t)sB[k] * DM + c); }
#pragma unroll
        for (int half = 0; half < 2; ++half) {
            if (half == 1 && !hasB) break;
            const int tok = half ? tokB : tokA, mr = tok < TL ? (tok >> 12) : 8;
            if (mr != cur_mr) { cur_mr = mr; const float* g2 = p.MOD + ((size_t)layer * 9 + mr) * 6144 + 5 * 1024;
                const float* gn = last ? p.final_g : p.norm1_g + (layer + 1) * 1024; const float* mod = p.MOD + ((size_t)(last ? layer : layer + 1) * 9 + mr) * 6144;
#pragma unroll
                for (int i = 0; i < 4; ++i) { const int c = 4 * lane + 256 * i; G2[i] = *(const f32x4*)(g2 + c);
                    if (last) { GN[i] = *(const f32x4*)(gn + c); } else { GN[i] = *(const f32x4*)(gn + c) * (*(const f32x4*)(mod + 1024 + c) + 1.0f); SH[i] = *(const f32x4*)(mod + c); } } }
            f32x4 v[4]; float ss = 0.f;
#pragma unroll
            for (int i = 0; i < 4; ++i) { f32x4 y = (f32x4){0.f, 0.f, 0.f, 0.f};
#pragma unroll
                for (int k = 0; k < 4; ++k) { const u32x2 w = half ? ob[i][k] : oa[i][k]; y += (f32x4){bflo(w.x), bfhi(w.x), bflo(w.y), bfhi(w.y)}; }
                { const u32x2 xw = half ? xb[i] : xa[i]; v[i] = (f32x4){bflo(xw.x), bfhi(xw.x), bflo(xw.y), bfhi(xw.y)} + G2[i] * y; } ss += (v[i][0] * v[i][0] + v[i][1] * v[i][1]) + (v[i][2] * v[i][2] + v[i][3] * v[i][3]); }
            const float r = rsqrtf(wave_sum(ss) * (1.0f / DM) + 1e-6f);
            if (!last) {
#pragma unroll
                for (int i = 0; i < 4; ++i) { const int c = 4 * lane + 256 * i; if (dry && v[i][0] != 1.2345678e-33f) continue; { u32x2 xw; xw.x = pk2(v[i][0], v[i][1]); xw.y = pk2(v[i][2], v[i][3]); *(u32x2*)(p.X + (size_t)tok * DM + c) = xw; }
                    const f32x4 h = (v[i] * r) * GN[i] + SH[i]; u32x2 w; w.x = pk2(h[0], h[1]); w.y = pk2(h[2], h[3]); *(u32x2*)(p.HX + (size_t)tok * DM + c) = w; }
            } else {
#pragma unroll
                for (int i = 0; i < 4; ++i) { const int c = 4 * lane + 256 * i; if (dry && v[i][0] != 1.2345678e-33f) continue; *(f32x4*)(p.out + (size_t)tok * DM + c) = (v[i] * r) * GN[i]; }
            }
        }
    }
}

DEVFN LAS float* epi_slot(char* smem, int it) { return (LAS float*)(smem + SMEM_GEMM + 1024 + (it & 1) * 4096); }
template <bool TRANS, class EPI>
DEVFN void dense_tile(char* smem, const bf16_t* A, const bf16_t* Bt, int K, int pm, int pn, const EPI& epi) {
    unsigned va[2][2], vb[2], vt[2]; lin_voff(vt, K); lin_voff_b(vb, K); va[0][0] = va[1][0] = vt[0]; va[0][1] = va[1][1] = vt[1];
    const char* a = (const char*)(A + (size_t)pm * 256 * K); const char* b = (const char*)(Bt + (size_t)pn * 256 * K); const size_t hs = (size_t)HALF * K * 2;
    gemm_tile<TRANS>(smem, a, a + hs, va, b, b + hs, vb, K / BK, epi);
}
DEVFN void phase_qkv(const Params& p, char* smem, int j) {
    const bf16_t* W = p.WQKV + (size_t)j * 3072 * 1024;
    bf16_t* Q = (bf16_t*)(p.BIG + NA_Q); bf16_t* Kb = (bf16_t*)(p.BIG + NA_K); bf16_t* VtL = (bf16_t*)(p.BIG + NA_VTL); bf16_t* VtC = (bf16_t*)(p.BIG + NA_VTC);
    int pm, pn;
    for (int it = 0; tile_order(it, TT / 256, 12, pm, pn); ++it) {
        if (pn < 8) { EpiQK epi{pn < 4 ? Q : Kb, pm * 256, (pn & 3) * 256, pn < 4 ? 0.125f * 1.44269504f : 1.0f}; dense_tile<true>(smem, p.HX, W, DM, pm, pn, epi); }
        else { EpiVt epi{VtL, VtC, pm * 256, (pn - 8) * 256}; dense_tile<false>(smem, p.HX, W, DM, pm, pn, epi); }
    }
    { const int rem = ((TT / 256) * 12) % (int)gridDim.x; if (rem && (int)blockIdx.x >= rem) conv_fill(p, smem, j ? 3 : 1, FILL_IN); }
}
DEVFN void phase_in_bf16(const Params& p, char* smem, const bf16_t* W, int N, const float* bias, bf16_t* dst, int gelu) {
    int pm, pn;
    for (int it = 0; tile_order(it, TT / 256, N / 256, pm, pn); ++it) { EpiBf16 epi{dst, N, pm * 256, pn * 256, bias, gelu, epi_slot(smem, it)}; epi.stage(); dense_tile<true>(smem, p.HX, W, DM, pm, pn, epi); }
    { const int rem = ((TT / 256) * (N / 256)) % (int)gridDim.x; if (rem && (int)blockIdx.x >= rem) conv_fill(p, smem, 1, FILL_IN); }
}
DEVFN void phase_gm_in(const Params& p, char* smem) {
    bf16_t* ZU = (bf16_t*)(p.BIG + GM_Z); bf16_t* VT = (bf16_t*)(p.BIG + GM_VT);
    constexpr int NU = (TT / 256) * 12;
    for (int it = 0;; ++it) {
        const long L = (long)it * gridDim.x + blockIdx.x; int pm, pn;
        if (L < NU) { tile_from_index(L, TT / 256, 12, pm, pn); EpiBf16 epi{ZU, 3072, pm * 256, pn * 256, p.gm_b_in, 1, epi_slot(smem, it)}; epi.stage(); dense_tile<true>(smem, p.HX, p.GMIN, DM, pm, pn, epi); }
        else if (tile_from_index(L - NU, 12, TT / 256, pm, pn)) { EpiVtG epi{VT, p.STAT, p.gm_b_in + 3072, pm * 256, pn * 256}; dense_tile<true>(smem, p.GMIN + (size_t)3072 * DM, p.HX, DM, pm, pn, epi); }
        else break;
    }
    { const int rem = (NU * 2) % (int)gridDim.x; if (rem && (int)blockIdx.x >= rem) conv_fill(p, smem, 2, FILL_IN); }
}
DEVFN void phase_outproj(const Params& p, char* smem, const bf16_t* A, const bf16_t* W, int K, const float* bias, int layer, int nrows) {
    int pm, pn;
    for (int rep = 0; rep < REP_OUT; ++rep) for (int it = 0; tile_order(it, nrows / 256, 4, pm, pn); ++it) { EpiResid epi{p.X, p.MOD + (size_t)layer * 9 * 6144 + 2 * 1024, bias, pm * 256, pn * 256, rep < REP_OUT - 1}; dense_tile<true>(smem, A, W, K, pm, pn, epi); }
    { const int rem = ((nrows / 256) * 4) % (int)gridDim.x; if (rem && (int)blockIdx.x >= rem) conv_fill(p, smem, layer < 1 ? 1 : layer, K == 3072 ? FILL_OUT3 : FILL_OUT); }
}

constexpr int NSEG = 32;
__global__ void __launch_bounds__(NTHREADS, 2) mega(Params p) {
    extern __shared__ __attribute__((aligned(16))) char smem[];
    volatile LAS unsigned* xbw = (volatile LAS unsigned*)(smem + SMEM_BYTES - 16);
    const bool single = (p.seg_hi - p.seg_lo) > 1;
    XcdBarrier bar; bar.bar = p.bar; bar.x = 0; bar.st = xbw;
    if (single) { if (TIDX == 0) { xbw[0] = 0u; xbw[1] = 0u; } __syncthreads(); bar = xcd_barrier_post(p.bar, xbw); }
    int seg = 0;
#if REP_BAR > 0
    if (single) for (int rep = 0; rep < REP_BAR; ++rep) xcd_barrier(bar);
#endif
#define SEG_BEGIN if (seg >= p.seg_lo && seg < p.seg_hi) {
#define SEG_END   if (single && seg + 1 < p.seg_hi) xcd_barrier(bar); } ++seg;

    SEG_BEGIN for (int rep = 0; rep < REP_P0; ++rep) phase_p0(p, smem); SEG_END
    SEG_BEGIN
        for (int rep = 0; rep < REP_P1A; ++rep) phase_n1_first(p);
        for (int rep = 0; rep < REP_P1B; ++rep) for (int u = blockIdx.x; u < 256 + 256; u += gridDim.x) { if (u < 256) hyb_unit<SEQ>(p, smem, u); else hyb_unit<CTXL>(p, smem, u - 256); }
    SEG_END
    for (int layer = 0; layer < 4; ++layer) {
        const int kind = layer % 3, j = layer / 3; const bool ctx_out = layer < 3;
        const bf16_t* oA; const bf16_t* oW; int oK; const float* oB;
        if (kind == 0) {
            SEG_BEGIN for (int rep = 0; rep < REP_QKV; ++rep) phase_qkv(p, smem, j); SEG_END
            SEG_BEGIN for (int rep = 0; rep < REP_ATTN; ++rep) phase_attn(p, smem, j, ctx_out); SEG_END
            oA = (const bf16_t*)(p.BIG + NA_O); oW = p.WO + (size_t)j * 1024 * 1024; oK = 1024; oB = nullptr;
        } else if (kind == 1) {
            SEG_BEGIN for (int rep = 0; rep < REP_DENSE; ++rep) phase_in_bf16(p, smem, p.HYIN, 3072, p.hy_b_in, (bf16_t*)(p.BIG + HY_U), 0); SEG_END
            SEG_BEGIN for (int rep = 0; rep < REP_MIXA; ++rep) phase_hy_gate(p, smem); SEG_END
            SEG_BEGIN
                for (int rep = 0; rep < REP_MIXB; ++rep) for (int u = blockIdx.x; u < 2048; u += gridDim.x) { if (u < 1024) hy_convmm_unit(p, smem, u); else hy_conv_unit<CTXL>(p, smem, u - 1024); }
            SEG_END
            SEG_BEGIN for (int rep = 0; rep < REP_MIXC; ++rep) phase_hy_post(p, smem); SEG_END
            oA = (const bf16_t*)(p.BIG + HY_YB); oW = p.HYOUT; oK = 1024; oB = p.hy_b_out;
        } else {
            SEG_BEGIN phase_gm_in(p, smem); SEG_END
            SEG_BEGIN for (int rep = 0; rep < REP_MIX2; ++rep) for (int u = blockIdx.x; u < 272 * 16; u += gridDim.x) gm_sp_unit(p, smem, u >> 4, u & 15); SEG_END
            oA = (const bf16_t*)(p.BIG + GM_UV); oW = p.GMOUT; oK = 3072; oB = p.gm_b_out;
        }
        const int nrows = ctx_out ? TT : TL;
        SEG_BEGIN phase_outproj(p, smem, oA, oW, oK, oB, layer, nrows); SEG_END
        SEG_BEGIN for (int rep = 0; rep < REP_N2; ++rep) phase_n2_route(p, smem, layer, nrows, rep < REP_N2 - 1); SEG_END
        SEG_BEGIN for (int rep = 0; rep < REP_MOE; ++rep) phase_moe1(p, smem, layer, rep < REP_MOE - 1 ? REP_DRY : 0); SEG_END
        SEG_BEGIN for (int rep = 0; rep < REP_MOE; ++rep) phase_moe2(p, smem, layer, rep < REP_MOE - 1 ? REP_DRY : 0); SEG_END
        SEG_BEGIN for (int rep = 0; rep < REP_COMB; ++rep) phase_combine(p, layer, layer == 3, rep < REP_COMB - 1); SEG_END
    }
}

extern "C" void kernel_launch(void* const* d_in, const int* in_sizes, int n_in, void* d_out, int out_size, void* d_ws, size_t ws_size, hipStream_t stream) {
    static int grid = 0;
    if (grid == 0) {
        int dev = 0, cus = 0;
        hipGetDevice(&dev); hipDeviceGetAttribute(&cus, hipDeviceAttributeMultiprocessorCount, dev);
        if (hipFuncSetAttribute((const void*)mega, hipFuncAttributeMaxDynamicSharedMemorySize, SMEM_BYTES) != hipSuccess) { grid = -1; return; }
        int per_cu = 0; (void)hipOccupancyMaxActiveBlocksPerMultiprocessor(&per_cu, (const void*)mega, NTHREADS, SMEM_BYTES); (void)hipGetLastError();
        grid = cus > 0 ? cus : 256;
    }
    if (grid < 0) return;
    Params p{};
    const float* const* in = (const float* const*)d_in;
    p.x = in[0]; p.c = in[1]; p.ctx = in[2]; p.c_ctx = in[3]; p.ada_w = in[4]; p.ada_b = in[5]; p.norm1_g = in[6]; p.norm2_g = in[7]; p.final_g = in[8];
    p.na_w_qkv = in[9]; p.na_rpb = in[10]; p.na_w_o = in[11];
    p.hy_w_in = in[12]; p.hy_b_in = in[13]; p.hy_conv_w = in[14]; p.hy_conv_b = in[15]; p.hy_f_w1 = in[16]; p.hy_f_b1 = in[17]; p.hy_f_w2 = in[18]; p.hy_f_b2 = in[19];
    p.hy_f_w3 = in[20]; p.hy_f_b3 = in[21]; p.hy_f_freq = in[22]; p.hy_f_wout = in[23]; p.hy_skip = in[24]; p.hy_w_out = in[25]; p.hy_b_out = in[26];
    p.gm_w_in = in[27]; p.gm_b_in = in[28]; p.gm_ln_g = in[29]; p.gm_ln_b = in[30]; p.gm_w_s = in[31]; p.gm_b_s = in[32]; p.gm_w_out = in[33]; p.gm_b_out = in[34];
    p.moe_router_w = in[35]; p.moe_router_b = in[36]; p.moe_w_gu = in[37]; p.moe_b_gu = in[38]; p.moe_w_dn = in[39]; p.moe_b_dn = in[40];
    p.out = (float*)d_out;
    unsigned char* ws = (unsigned char*)d_ws; size_t off = 0;
    auto carve = [&](size_t bytes) { unsigned char* r = ws + off; off += (bytes + 255) & ~(size_t)255; return r; };
    p.bar = (unsigned*)carve(XCD_BAR_WORDS * 4);
    p.cnt = (int*)carve(144 * 4);
    p.X = (bf16_t*)carve((size_t)TT * DM * 2);
    p.HX = (bf16_t*)carve(SZ_TD);
    p.MOD = (float*)carve((size_t)4 * 9 * 6144 * 4);
    p.WQKV = (bf16_t*)carve((size_t)2 * 3072 * 1024 * 2);
    p.WO = (bf16_t*)carve((size_t)2 * 1024 * 1024 * 2);
    p.HYIN = (bf16_t*)carve((size_t)3072 * 1024 * 2);
    p.HYOUT = (bf16_t*)carve((size_t)1024 * 1024 * 2);
    p.GMIN = (bf16_t*)carve((size_t)6144 * 1024 * 2);
    p.GMOUT = (bf16_t*)carve((size_t)1024 * 3072 * 2);
    p.GMWS = (bf16_t*)carve((size_t)16 * 128 * 128 * 2);
    p.MOEGU = (bf16_t*)carve((size_t)128 * 2048 * 1024 * 2);
    p.MOEDN = (bf16_t*)carve((size_t)128 * 1024 * 1024 * 2);
    p.FA = (float*)carve((size_t)(SEQ + CTXL) * 64 * 4);
    p.RK4 = (bf16_t*)carve((size_t)1024 * 4 * 8192 * 2);
    p.KC = (float*)carve((size_t)1024 * 512 * 4);
    p.toklist = (int*)carve((size_t)32 * TT * 4);
    p.gatelist = (float*)carve((size_t)32 * TT * 4);
    p.assign = (int*)carve((size_t)TT * 4 * 4);
    p.ACT = (bf16_t*)carve((size_t)MOE_ROWS * DM * 2);
    p.OUTS = (bf16_t*)carve((size_t)MOE_ROWS * DM * 2);
    p.STAT = (float*)carve((size_t)TT * 48 * 4);
    p.GMS0 = (float*)carve((size_t)16 * 128 * 4);
    p.BIG = carve(BIG_BYTES);
    if (off > ws_size) return;
    hipMemsetAsync(p.bar, 0, XCD_BAR_WORDS * 4, stream);
#if MK_SINGLE
    p.seg_lo = 0; p.seg_hi = NSEG;
    hipLaunchKernelGGL(mega, dim3(grid), dim3(NTHREADS), SMEM_BYTES, stream, p);
#else
    for (int s = 0; s < NSEG; ++s) { p.seg_lo = s; p.seg_hi = s + 1; hipLaunchKernelGGL(mega, dim3(grid), dim3(NTHREADS), SMEM_BYTES, stream, p); }
#endif
}
```

```cpp
#include <hip/hip_runtime.h>
#include <stdint.h>
#include <math.h>

#ifndef GEMM_SP2
#define GEMM_SP2 1
#endif
#ifndef MK_SINGLE
#define MK_SINGLE 1
#endif

#ifndef REP_ATTN
#define REP_ATTN 1
#endif
#ifndef REP_P0
#define REP_P0 1
#endif
#ifndef REP_MOE
#define REP_MOE 1
#endif
#ifndef REP_DENSE
#define REP_DENSE 1
#endif
#ifndef REP_MIX
#define REP_MIX 1
#endif
#ifndef REP_QKV
#define REP_QKV 1
#endif
#ifndef REP_GMIN
#define REP_GMIN 1
#endif
#ifndef REP_BAR
#define REP_BAR 0
#endif
#ifndef REP_OUT
#define REP_OUT 1
#endif
#ifndef REP_DRY
#define REP_DRY 0
#endif
#ifndef REP_N2
#define REP_N2 1
#endif
#ifndef REP_COMB
#define REP_COMB 1
#endif
#ifndef REP_P1A
#define REP_P1A 1
#endif
#ifndef REP_P1B
#define REP_P1B 1
#endif
#ifndef ATTN_PROBE
#define ATTN_PROBE 0
#endif
#ifndef REP_MIXA
#define REP_MIXA 1
#endif
#ifndef REP_MIXB
#define REP_MIXB 1
#endif
#ifndef REP_MIXC
#define REP_MIXC 1
#endif
#ifndef REP_MIX2
#define REP_MIX2 1
#endif
#define DEVFN __device__ __forceinline__
typedef unsigned short bf16_t;
typedef short bf16x8 __attribute__((ext_vector_type(8)));
typedef float f32x4 __attribute__((ext_vector_type(4)));
typedef float f32x2 __attribute__((ext_vector_type(2)));
typedef unsigned u32x4 __attribute__((ext_vector_type(4)));
typedef unsigned u32x2 __attribute__((ext_vector_type(2)));

constexpr int DM = 1024, NB = 8, SEQ = 4096, CTXL = 256, TL = NB * SEQ, TC = NB * CTXL, TT = TL + TC;
constexpr int NEXP = 32, MOE_ROWS = 4 * TT + NEXP * 256;
constexpr int SMEM_GEMM = 131072, SMEM_MISC = 12288, SMEM_BYTES = 158 * 1024;
constexpr int NTHREADS = 512;

#define XB_TMO      128
#define XB_XCNT(j)  (256  + 64 * (j))
#define XB_XSUB(j)  (1280 + 64 * (j))
#define XB_XGEN(j)  (2304 + 64 * (j))
#define XB_TOP      3328
#define XB_TOPGEN   3392
#define XCD_BAR_WORDS 3456
#define XB_SPIN_CAP (1u << 18)
#define LAS __attribute__((address_space(3)))

__device__ __forceinline__ unsigned xb_ld(unsigned* p)              { return __hip_atomic_load(p, __ATOMIC_RELAXED, __HIP_MEMORY_SCOPE_AGENT); }
__device__ __forceinline__ unsigned xb_add(unsigned* p, unsigned v) { return __hip_atomic_fetch_add(p, v, __ATOMIC_RELAXED, __HIP_MEMORY_SCOPE_AGENT); }
__device__ __forceinline__ unsigned xb_xcc_id() { return (unsigned)__builtin_amdgcn_s_getreg((3 << 11) | 20) & 0xFu; }
#define XB_SPIN(cond, bar) do { unsigned _sp = 0; while (cond) { __builtin_amdgcn_s_sleep(1); \
    if ((++_sp & 255u) == 0u) { if (xb_ld(&(bar)[XB_TMO])) break; if (_sp > XB_SPIN_CAP) { atomicAdd(&(bar)[XB_TMO], 1u); break; } } } } while (0)

struct XcdBarrier { unsigned* bar; unsigned x; volatile LAS unsigned* st; };

__device__ __forceinline__ XcdBarrier xcd_barrier_post(unsigned* bar, volatile LAS unsigned* st) {
    XcdBarrier b; b.bar = bar; b.x = xb_xcc_id(); b.st = st;
    if (threadIdx.x == 0) (void)xb_add(&bar[XB_XCNT(b.x)], 1u);
    return b;
}
__device__ __forceinline__ void xcd_barrier_complete(unsigned* bar, unsigned x, unsigned& nloc, unsigned& nx) {
    const unsigned G = gridDim.x * gridDim.y * gridDim.z;
    unsigned sum, cnt, mine, sp = 0u;
    for (;;) {
        sum = 0u; cnt = 0u; mine = 0u;
#pragma unroll
        for (unsigned j = 0; j < 16; ++j) { const unsigned c = xb_ld(&bar[XB_XCNT(j)]); sum += c; cnt += (c > 0u) ? 1u : 0u; mine = (j == x) ? c : mine; }
        if (sum == G) break;
        __builtin_amdgcn_s_sleep(1);
        if ((++sp & 255u) == 0u) { if (xb_ld(&bar[XB_TMO])) break; if (sp > XB_SPIN_CAP) { atomicAdd(&bar[XB_TMO], 1u); break; } }
    }
    nloc = mine > 0u ? mine : 1u; nx = cnt > 0u ? cnt : 1u;
}
__device__ __forceinline__ void xcd_barrier(const XcdBarrier& b) {
    asm volatile("s_waitcnt vmcnt(0)" ::: "memory");
    __syncthreads();
    if (threadIdx.x == 0) {
        unsigned* bar = b.bar;
        __builtin_amdgcn_s_waitcnt(0);
        unsigned nloc = b.st[0], nx = b.st[1];
        if (nloc == 0u) { xcd_barrier_complete(bar, b.x, nloc, nx); b.st[0] = nloc; b.st[1] = nx; }
        const unsigned old = xb_add(&bar[XB_XSUB(b.x)], 1u);
        const unsigned gen = old / nloc;
        if (old + 1u == (gen + 1u) * nloc) {
            __builtin_amdgcn_fence(__ATOMIC_RELEASE, "agent");
            asm volatile("s_waitcnt vmcnt(0)" ::: "memory");
            const unsigned og = xb_add(&bar[XB_TOP], 1u);
            const unsigned tg = og / nx;
            if (og + 1u == (tg + 1u) * nx) xb_add(&bar[XB_TOPGEN], 1u);
            else XB_SPIN(xb_ld(&bar[XB_TOPGEN]) == tg, bar);
            __builtin_amdgcn_fence(__ATOMIC_ACQUIRE, "agent");
            xb_add(&bar[XB_XGEN(b.x)], 1u);
            asm volatile("s_waitcnt vmcnt(0)" ::: "memory");
        } else {
            XB_SPIN(xb_ld(&bar[XB_XGEN(b.x)]) == gen, bar);
            __builtin_amdgcn_fence(__ATOMIC_ACQUIRE, "agent");
            asm volatile("s_waitcnt vmcnt(0)" ::: "memory");
        }
    }
    __syncthreads();
}

struct Params {
    const float *x, *c, *ctx, *c_ctx, *ada_w, *ada_b, *norm1_g, *norm2_g, *final_g;
    const float *na_w_qkv, *na_rpb, *na_w_o;
    const float *hy_w_in, *hy_b_in, *hy_conv_w, *hy_conv_b, *hy_f_w1, *hy_f_b1, *hy_f_w2, *hy_f_b2, *hy_f_w3, *hy_f_b3, *hy_f_freq, *hy_f_wout, *hy_skip, *hy_w_out, *hy_b_out;
    const float *gm_w_in, *gm_b_in, *gm_ln_g, *gm_ln_b, *gm_w_s, *gm_b_s, *gm_w_out, *gm_b_out;
    const float *moe_router_w, *moe_router_b, *moe_w_gu, *moe_b_gu, *moe_w_dn, *moe_b_dn;
    float* out;
    unsigned* bar;
    int* cnt;
    bf16_t* X;
    bf16_t* HX;
    float* MOD;
    bf16_t *WQKV, *WO, *HYIN, *HYOUT, *GMIN, *GMOUT, *GMWS, *MOEGU, *MOEDN;
    float* FA;
    bf16_t* RK4;
    float* KC;
    int* toklist;
    float* gatelist;
    int* assign;
    bf16_t* ACT;
    bf16_t* OUTS;
    float* STAT;
    float* GMS0;
    unsigned char* BIG;
    int seg_lo, seg_hi;
};

constexpr size_t SZ_TD = (size_t)TT * DM * 2;
constexpr size_t NA_Q = 0, NA_K = SZ_TD, NA_VTL = 2 * SZ_TD, NA_VTC = NA_VTL + (size_t)TL * DM * 2, NA_O = NA_VTC + (size_t)TC * DM * 2, NA_END = NA_O + SZ_TD;
constexpr size_t HY_U = 0, HY_X0 = 3 * SZ_TD, HY_VXTL = HY_X0 + SZ_TD, HY_VXTC = HY_VXTL + (size_t)TL * DM * 2, HY_YTL = HY_VXTC + (size_t)TC * DM * 2,
                 HY_YTC = HY_YTL + (size_t)TL * DM * 2, HY_YB = HY_YTC + (size_t)TC * DM * 2, HY_END = HY_YB + SZ_TD;
constexpr size_t GM_Z = 0, GM_VT = 6 * SZ_TD, GM_UV = 9 * SZ_TD, GM_END = 12 * SZ_TD;
constexpr size_t BIG_BYTES = GM_END;

DEVFN int tidx() { int t = threadIdx.x; asm volatile("" : "+v"(t)); return t; }
#define TIDX tidx()
typedef __bf16 bf16x2_t __attribute__((ext_vector_type(2)));
DEVFN unsigned pk2(float lo, float hi) { f32x2 v = {lo, hi}; bf16x2_t r = __builtin_convertvector(v, bf16x2_t); return __builtin_bit_cast(unsigned, r); }
DEVFN float bflo(unsigned u) { return __uint_as_float(u << 16); }
DEVFN float bfhi(unsigned u) { return __uint_as_float(u & 0xffff0000u); }
DEVFN float bf2f(bf16_t b) { return __uint_as_float((unsigned)b << 16); }
DEVFN float wave_sum(float v) {
#pragma unroll
    for (int o = 1; o < 64; o <<= 1) v += __shfl_xor(v, o);
    return v;
}
DEVFN f32x2 gelu_pk(f32x2 v) {
    f32x2 a = __builtin_elementwise_abs(v); a.x = fminf(a.x, 6.0f); a.y = fminf(a.y, 6.0f);
    f32x2 q = a * (-3.115766594419256e-05f) + 0.000740654009860009f; q = q * a + (-0.00794870126992464f); q = q * a + 0.05315221846103668f; q = q * a + 0.4589992165565491f; q = q * a + 1.1511220932006836f; q = q * a + 1.0f;
    f32x2 t; t.x = __builtin_amdgcn_exp2f(-q.x); t.y = __builtin_amdgcn_exp2f(-q.y);
    const f32x2 m = v * t, r = v - m;
    f32x2 o; o.x = v.x < 0.f ? m.x : r.x; o.y = v.y < 0.f ? m.y : r.y; return o;
}

constexpr int BM = 256, BK = 64, HALF = 128, HTB = HALF * BK * 2;
DEVFN int lds_byte(int r, int c) { int st = (r >> 4) * 2 + (c >> 5), rr = r & 15, cc = c & 31, ob = rr * 64 + cc * 2; return st * 1024 + (ob ^ (((ob >> 9) & 1) << 5)); }
DEVFN void stage_rc(int b, int& R, int& C) { int st = b / 1024, sb = b % 1024, swz = sb ^ (((sb >> 9) & 1) << 5); R = (st >> 1) * 16 + swz / 64; C = (st & 1) * 32 + (swz % 64) / 2; }

template <bool TRANS, class EPI, int KSA = BK * 2, int KSB = BK * 2>
DEVFN void gemm_tile(char* smem, const char* A0, const char* A1, const unsigned (&va)[2][2], const char* B0p, const char* B1p, const unsigned (&vb)[2], int nt, const EPI& epi) {
    LAS unsigned char* lds = (LAS unsigned char*)smem;
    const int tid = TIDX, wid = __builtin_amdgcn_readfirstlane(tid >> 6), lane = tid & 63, wr = wid >> 2, wc = wid & 3, fr = lane & 15, fq = lane >> 4;
    const unsigned ldsw = (unsigned)wid * 1024u;
    const int aoff = KSA == 2048 ? wr * 8192 + lane * 16 : lds_byte(wr * 64 + fr, fq * 8), boff = KSB == 2048 ? wc * 4096 + lane * 16 : lds_byte(wc * 32 + fr, fq * 8);
#define SA(b,h) (((b)*2+(h))*HTB)
#define SB(b,h) ((4+(b)*2+(h))*HTB)
#define STAGE(bufoff,gbase,voff) do{ _Pragma("unroll") for(int _i=0;_i<2;++_i) \
      __builtin_amdgcn_global_load_lds((const unsigned*)((const char*)(gbase)+(voff)[_i]), (LAS unsigned*)(lds+(bufoff)+ldsw+_i*8192),16,0,0);}while(0)
#define LDA(dst,b,h) do{ _Pragma("unroll") for(int m=0;m<4;++m) _Pragma("unroll") for(int k=0;k<2;++k) dst[m][k]=*(const LAS bf16x8*)(lds+SA(b,h)+aoff+m*2048+k*1024);}while(0)
#define LDB(dst,b,h) do{ _Pragma("unroll") for(int n=0;n<2;++n) _Pragma("unroll") for(int k=0;k<2;++k) dst[n][k]=*(const LAS bf16x8*)(lds+SB(b,h)+boff+n*2048+k*1024);}while(0)
#define MMA(ai,bj,At_,Bt_) do{__builtin_amdgcn_s_setprio(1); \
    _Pragma("unroll") for(int m=0;m<4;++m) _Pragma("unroll") for(int n=0;n<2;++n) _Pragma("unroll") for(int k=0;k<2;++k) \
      acc[ai][bj][m][n]= TRANS ? __builtin_amdgcn_mfma_f32_16x16x32_bf16(Bt_[n][k],At_[m][k],acc[ai][bj][m][n],0,0,0) \
                               : __builtin_amdgcn_mfma_f32_16x16x32_bf16(At_[m][k],Bt_[n][k],acc[ai][bj][m][n],0,0,0); \
    __builtin_amdgcn_s_setprio(0);}while(0)
#define WAIT_V(n) asm volatile("s_waitcnt vmcnt(" #n ")":::"memory")
#define WAIT_L(n) asm volatile("s_waitcnt lgkmcnt(" #n ")":::"memory")
#define BAR __builtin_amdgcn_s_barrier()
#define SCHED __builtin_amdgcn_sched_barrier(0)
    f32x4 acc[2][2][4][2];
    const auto pre = epi.pre(wc, fq);
    bf16x8 At[4][2], B0[2][2], B1[2][2];
    const size_t ks = (size_t)KSB;
#if GEMM_SP2
    STAGE(SB(0,0),B0p,vb); STAGE(SB(0,1),B1p,vb); STAGE(SA(0,0),A0,va[0]); STAGE(SA(0,1),A1,va[1]);
    if(wr==1)BAR;
    WAIT_V(2); BAR;
    STAGE(SB(1,0),B0p+ks,vb); STAGE(SA(1,0),A0+KSA,va[0]); STAGE(SB(1,1),B1p+ks,vb);
    WAIT_V(6); BAR;
    epi.init(acc, pre);
    for(int t=0;t<nt;t+=2){
        const bool last = (t == nt - 2);
        const size_t o1 = (size_t)(t+1)*ks, o2 = last ? 0 : (size_t)(t+2)*ks, o3 = o2 + ks; (void)o1;
        const size_t a1 = (size_t)(t+1)*KSA, a2 = last ? 0 : (size_t)(t+2)*KSA, a3 = a2 + KSA;
        LDB(B0,0,0); LDB(B1,0,1); SCHED; LDA(At,0,0); STAGE(SA(1,1),A1+a1,va[1]);
        WAIT_V(8); WAIT_L(0); BAR; MMA(0,0,At,B0); MMA(0,1,At,B1); BAR; SCHED;
        LDA(At,0,1); STAGE(SB(0,0),B0p+o2,vb); STAGE(SB(0,1),B1p+o2,vb); STAGE(SA(0,0),A0+a2,va[0]);
        WAIT_V(8); WAIT_L(0); BAR; MMA(1,0,At,B0); MMA(1,1,At,B1); BAR; SCHED;
        LDB(B0,1,0); LDB(B1,1,1); SCHED; LDA(At,1,0); STAGE(SA(0,1),A1+a2,va[1]);
        WAIT_V(8); WAIT_L(0); BAR; MMA(0,0,At,B0); MMA(0,1,At,B1); BAR; SCHED;
        LDA(At,1,1); STAGE(SB(1,0),B0p+o3,vb); STAGE(SB(1,1),B1p+o3,vb); STAGE(SA(1,0),A0+a3,va[0]);
        WAIT_V(8); WAIT_L(0); BAR; MMA(1,0,At,B0); MMA(1,1,At,B1); BAR; SCHED;
    }
    WAIT_V(0);
    if(wr==0)BAR;
    BAR;
    epi(acc, wr, wc, fr, fq);
#else
    STAGE(SB(0,0),B0p,vb); STAGE(SA(0,0),A0,va[0]);
    STAGE(SB(0,1),B1p,vb); STAGE(SA(0,1),A1,va[1]);
    if(wr==1)BAR;
    WAIT_V(4); BAR;
    STAGE(SB(1,0),B0p+ks,vb); STAGE(SA(1,0),A0+KSA,va[0]); STAGE(SB(1,1),B1p+ks,vb);
    WAIT_V(6); BAR;
    epi.init(acc, pre);
    for(int t=0;t<nt-2;t+=2){
        const char* a0t1 = A0 + (size_t)(t+1)*ks; (void)a0t1;
        const size_t o1 = (size_t)(t+1)*ks, o2 = (size_t)(t+2)*ks, o3 = (size_t)(t+3)*ks; (void)o1;
        const size_t a1 = (size_t)(t+1)*KSA, a2 = (size_t)(t+2)*KSA, a3 = (size_t)(t+3)*KSA;
        LDB(B0,0,0); SCHED; LDA(At,0,0); STAGE(SA(1,1),A1+a1,va[1]);
        WAIT_L(8); BAR; WAIT_L(0); MMA(0,0,At,B0); BAR; SCHED;
        LDB(B1,0,1); STAGE(SB(0,0),B0p+o2,vb);
        BAR; WAIT_L(0); MMA(0,1,At,B1); BAR;
        LDA(At,0,1); STAGE(SA(0,0),A0+a2,va[0]);
        BAR; WAIT_L(0); MMA(1,0,At,B0); BAR; SCHED;
        STAGE(SB(0,1),B1p+o2,vb);
        WAIT_V(6); BAR; MMA(1,1,At,B1); BAR;
        LDB(B0,1,0); SCHED; LDA(At,1,0); STAGE(SA(0,1),A1+a2,va[1]);
        WAIT_L(8); BAR; WAIT_L(0); MMA(0,0,At,B0); BAR; SCHED;
        LDB(B1,1,1); STAGE(SB(1,0),B0p+o3,vb);
        BAR; WAIT_L(0); MMA(0,1,At,B1); BAR;
        LDA(At,1,1); STAGE(SA(1,0),A0+a3,va[0]);
        BAR; WAIT_L(0); MMA(1,0,At,B0); BAR; SCHED;
        STAGE(SB(1,1),B1p+o3,vb);
        WAIT_V(6); BAR; MMA(1,1,At,B1); BAR;
    }
    { LDB(B0,0,0); WAIT_V(0); LDA(At,0,0); STAGE(SA(1,1),A1+(size_t)(nt-1)*KSA,va[1]);
      BAR; WAIT_L(0); MMA(0,0,At,B0); BAR;
      LDB(B1,0,1); BAR; WAIT_L(0); MMA(0,1,At,B1); BAR;
      LDA(At,0,1); WAIT_V(4); BAR; WAIT_L(0); MMA(1,0,At,B0); MMA(1,1,At,B1); BAR; }
    { LDB(B0,1,0); LDA(At,1,0); WAIT_V(2); BAR; WAIT_L(0); MMA(0,0,At,B0); BAR;
      LDB(B1,1,1); WAIT_V(0); BAR; WAIT_L(0); MMA(0,1,At,B1); BAR;
      LDA(At,1,1); BAR; WAIT_L(0); MMA(1,0,At,B0); MMA(1,1,At,B1); BAR; }
    if(wr==0)BAR;
    epi(acc, wr, wc, fr, fq);
#endif
#undef SA
#undef SB
#undef STAGE
#undef LDA
#undef LDB
#undef MMA
}

template <bool GATHER, class EPI, class PROV>
DEVFN void gemm_stream(char* smem, const PROV& S, int nt, size_t hstepA, size_t hstepB, int ldA, int ldB) {
    LAS unsigned char* lds = (LAS unsigned char*)smem;
    const int tid = TIDX, wid = __builtin_amdgcn_readfirstlane(tid >> 6), lane = tid & 63, wr = wid >> 2, wc = wid & 3, fr = lane & 15, fq = lane >> 4;
    const unsigned ldsw = (unsigned)wid * 1024u;
    const int aoff = lds_byte(wr * 64 + fr, fq * 8), boff = lds_byte(wc * 32 + fr, fq * 8);
    unsigned vb[2], vaC[2][2], vaN[2][2];
#pragma unroll
    for (int i = 0; i < 2; ++i) { int r, c; stage_rc(tid * 16 + i * 8192, r, c); { const int rr = r & 31, n = rr >> 4, ii = rr & 15, rb = (r & ~31) + 8 * (ii >> 2) + 4 * n + (ii & 3); vb[i] = (unsigned)(rb * ldB + c) * 2u; } vaC[0][i] = vaC[1][i] = vaN[0][i] = vaN[1][i] = (unsigned)(r * ldA + c) * 2u; }
#define SA(b,h) (((b)*2+(h))*HTB)
#define SB(b,h) ((4+(b)*2+(h))*HTB)
#define STAGE(bufoff,gbase,voff) do{ _Pragma("unroll") for(int _i=0;_i<2;++_i) \
      __builtin_amdgcn_global_load_lds((const unsigned*)((const char*)(gbase)+(voff)[_i]), (LAS unsigned*)(lds+(bufoff)+ldsw+_i*8192),16,0,0);}while(0)
#define LDA(dst,b,h) do{ _Pragma("unroll") for(int m=0;m<4;++m) _Pragma("unroll") for(int k=0;k<2;++k) dst[m][k]=*(const LAS bf16x8*)(lds+SA(b,h)+aoff+m*2048+k*1024);}while(0)
#define LDB(dst,b,h) do{ _Pragma("unroll") for(int n=0;n<2;++n) _Pragma("unroll") for(int k=0;k<2;++k) dst[n][k]=*(const LAS bf16x8*)(lds+SB(b,h)+boff+n*2048+k*1024);}while(0)
#define MMA(ai,bj,At_,Bt_) do{__builtin_amdgcn_s_setprio(1); \
    _Pragma("unroll") for(int m=0;m<4;++m) _Pragma("unroll") for(int n=0;n<2;++n) _Pragma("unroll") for(int k=0;k<2;++k) \
      acc[ai][bj][m][n]=__builtin_amdgcn_mfma_f32_16x16x32_bf16(Bt_[n][k],At_[m][k],acc[ai][bj][m][n],0,0,0); \
    __builtin_amdgcn_s_setprio(0);}while(0)
    const char *cA, *cB, *nA, *nB; EPI cE, nE;
    if (!S.next(0, cA, cB, vaC, cE)) return;
    f32x4 acc[2][2][4][2];
#pragma unroll
    for (int a = 0; a < 2; ++a)
#pragma unroll
        for (int b = 0; b < 2; ++b)
#pragma unroll
            for (int m = 0; m < 4; ++m)
#pragma unroll
                for (int n = 0; n < 2; ++n) acc[a][b][m][n] = (f32x4){0.f, 0.f, 0.f, 0.f};
    bf16x8 At[4][2], B0[2][2], B1[2][2];
    const size_t ks = (size_t)(BK * 2);
    STAGE(SB(0,0),cB,vb); STAGE(SA(0,0),cA,vaC[0]); STAGE(SB(0,1),cB+hstepB,vb); STAGE(SA(0,1),cA+hstepA,vaC[1]);
    if(wr==1)BAR;
    WAIT_V(4); BAR;
    STAGE(SB(1,0),cB+ks,vb); STAGE(SA(1,0),cA+ks,vaC[0]); STAGE(SB(1,1),cB+hstepB+ks,vb);
    WAIT_V(6); BAR;
    for (int ui = 0;;) {
        const bool has_next = S.next(ui + 1, nA, nB, vaN, nE);
        if (!has_next) { nA = cA; nB = cB; if (GATHER) {
#pragma unroll
            for (int h = 0; h < 2; ++h)
#pragma unroll
                for (int i = 0; i < 2; ++i) vaN[h][i] = vaC[h][i]; } }
        for (int t = 0; t < nt; t += 2) {
            const bool last = (t == nt - 2);
            const char* a1 = cA + (size_t)(t + 1) * ks;
            const char* a2 = last ? nA : cA + (size_t)(t + 2) * ks; const char* b2 = last ? nB : cB + (size_t)(t + 2) * ks;
            const char* a3 = a2 + ks; const char* b3 = b2 + ks;
            unsigned v2[2][2];
#pragma unroll
            for (int h = 0; h < 2; ++h)
#pragma unroll
                for (int i = 0; i < 2; ++i) v2[h][i] = (GATHER && last) ? vaN[h][i] : vaC[h][i];
            LDB(B0,0,0); SCHED; LDA(At,0,0); STAGE(SA(1,1),a1+hstepA,vaC[1]);
            WAIT_L(8); BAR; WAIT_L(0); MMA(0,0,At,B0); BAR; SCHED;
            LDB(B1,0,1); STAGE(SB(0,0),b2,vb);
            BAR; WAIT_L(0); MMA(0,1,At,B1); BAR;
            LDA(At,0,1); STAGE(SA(0,0),a2,v2[0]);
            BAR; WAIT_L(0); MMA(1,0,At,B0); BAR; SCHED;
            STAGE(SB(0,1),b2+hstepB,vb);
            WAIT_V(6); BAR; MMA(1,1,At,B1); BAR;
            LDB(B0,1,0); SCHED; LDA(At,1,0); STAGE(SA(0,1),a2+hstepA,v2[1]);
            WAIT_L(8); BAR; WAIT_L(0); MMA(0,0,At,B0); BAR; SCHED;
            LDB(B1,1,1); STAGE(SB(1,0),b3,vb);
            BAR; WAIT_L(0); MMA(0,1,At,B1); BAR;
            LDA(At,1,1); STAGE(SA(1,0),a3,v2[0]);
            BAR; WAIT_L(0); MMA(1,0,At,B0); BAR; SCHED;
            STAGE(SB(1,1),b3+hstepB,vb);
            WAIT_V(6); BAR; MMA(1,1,At,B1); BAR;
        }
        cE(acc, wr, wc, fr, fq);
        if (!has_next) break;
#pragma unroll
        for (int a = 0; a < 2; ++a)
#pragma unroll
            for (int b = 0; b < 2; ++b)
#pragma unroll
                for (int m = 0; m < 4; ++m)
#pragma unroll
                    for (int n = 0; n < 2; ++n) acc[a][b][m][n] = (f32x4){0.f, 0.f, 0.f, 0.f};
        cA = nA; cB = nB; cE = nE; ++ui;
        if (GATHER) {
#pragma unroll
            for (int h = 0; h < 2; ++h)
#pragma unroll
                for (int i = 0; i < 2; ++i) vaC[h][i] = vaN[h][i]; }
    }
    WAIT_V(0);
    if (wr == 0) BAR;
    BAR;
#undef SA
#undef SB
#undef STAGE
#undef LDA
#undef LDB
#undef MMA
}

DEVFN void lin_voff(unsigned (&v)[2], int ld) {
#pragma unroll
    for (int i = 0; i < 2; ++i) { int r, c; stage_rc((int)TIDX * 16 + i * 8192, r, c); v[i] = (unsigned)(r * ld + c) * 2u; }
}
DEVFN size_t blk_elem(int r, int c) { return ((size_t)(r >> 4) * (DM / 8) + (c >> 3)) * 128 + (r & 15) * 8 + (c & 7); }
DEVFN void blk_voff(unsigned (&v)[2]) {
#pragma unroll
    for (int i = 0; i < 2; ++i) { const int b = (int)TIDX * 16 + i * 8192, st = b >> 10; v[i] = (unsigned)blk_elem((st >> 1) * 16, (st & 1) * 32) * 2u + (unsigned)(b & 1023); }
}
DEVFN void blk_voff_k(unsigned (&v)[2], int K) {
#pragma unroll
    for (int i = 0; i < 2; ++i) { const int b = (int)TIDX * 16 + i * 8192, st = b >> 10; v[i] = (unsigned)(((st >> 1) * (K >> 3) + (st & 1) * 4) * 256) + (unsigned)(b & 1023); }
}
DEVFN void lin_voff_b(unsigned (&v)[2], int ld) {
#pragma unroll
    for (int i = 0; i < 2; ++i) { int r, c; stage_rc(TIDX * 16 + i * 8192, r, c); const int rr = r & 31, n = rr >> 4, ii = rr & 15, rb = (r & ~31) + 8 * (ii >> 2) + 4 * n + (ii & 3); v[i] = (unsigned)(rb * ld + c) * 2u; }
}
DEVFN bool tile_from_index(long L, int nM, int nN, int& pm, int& pn) {
    const int nwg = nM * nN; if (L >= nwg) return false;
    int wgid = (int)L; { const int q = nwg / 8, r = nwg % 8, xcd = wgid % 8, off = wgid / 8; wgid = (xcd < r ? xcd * (q + 1) : r * (q + 1) + (xcd - r) * q) + off; }
    const int nig = 8 * nN, gid = wgid / nig, fm = gid * 8, gsz = (nM - fm) < 8 ? (nM - fm) : 8;
    pm = fm + ((wgid % nig) % gsz); pn = (wgid % nig) / gsz; return true;
}
DEVFN bool tile_order(int it, int nM, int nN, int& pm, int& pn) { return tile_from_index((long)it * gridDim.x + blockIdx.x, nM, nN, pm, pn); }

DEVFN size_t blk_elem_k(int r, int c, int K) { return ((size_t)(r >> 4) * (K >> 3) + (c >> 3)) * 128 + (r & 15) * 8 + (c & 7); }
struct NoPre {};
DEVFN void acc_zero(f32x4 (&acc)[2][2][4][2]) {
#pragma unroll
    for (int a = 0; a < 2; ++a)
#pragma unroll
        for (int b = 0; b < 2; ++b)
#pragma unroll
            for (int m = 0; m < 4; ++m)
#pragma unroll
                for (int n = 0; n < 2; ++n) acc[a][b][m][n] = (f32x4){0.f, 0.f, 0.f, 0.f};
}
struct BiasPre { f32x4 b[2][2]; };
DEVFN void acc_bias(f32x4 (&acc)[2][2][4][2], const BiasPre& pre) {
#pragma unroll
    for (int a = 0; a < 2; ++a)
#pragma unroll
        for (int b = 0; b < 2; ++b)
#pragma unroll
            for (int m = 0; m < 4; ++m)
#pragma unroll
                for (int n = 0; n < 2; ++n) acc[a][b][m][n] = pre.b[b][n];
}
#define EPI_NOPRE DEVFN NoPre pre(int, int) const { return NoPre{}; } DEVFN void init(f32x4 (&acc)[2][2][4][2], const NoPre&) const { acc_zero(acc); }
DEVFN u32x4 pack8(const f32x4& a, const f32x4& b) { u32x4 w; w.x = pk2(a[0], a[1]); w.y = pk2(a[2], a[3]); w.z = pk2(b[0], b[1]); w.w = pk2(b[2], b[3]); return w; }
struct EpiQK {
    bf16_t* dst; int row0, col0; float scale; int kblk;
    EPI_NOPRE
    DEVFN void operator()(const f32x4 (&acc)[2][2][4][2], int wr, int wc, int fr, int fq) const {
#pragma unroll
        for (int ai = 0; ai < 2; ++ai)
#pragma unroll
            for (int m = 0; m < 4; ++m) { const int row = row0 + ai * 128 + wr * 64 + m * 16 + fr;
#pragma unroll
                for (int bj = 0; bj < 2; ++bj) { const int col = col0 + bj * 128 + wc * 32 + 8 * fq;
                    *(u32x4*)(dst + (kblk ? ((size_t)(row >> 3) * 128 + (col >> 3)) * 64 + (row & 7) * 8 : blk_elem_k(row, col, DM))) = pack8(acc[ai][bj][m][0] * scale, acc[ai][bj][m][1] * scale); } }
    }
};
struct EpiVt {
    bf16_t* vtl; bf16_t* vtc; int row0, vc0;
    EPI_NOPRE
    DEVFN void operator()(const f32x4 (&acc)[2][2][4][2], int wr, int wc, int fr, int fq) const {
#pragma unroll
        for (int ai = 0; ai < 2; ++ai)
#pragma unroll
            for (int m = 0; m < 4; ++m) { const int row = row0 + ai * 128 + wr * 64 + m * 16 + 4 * fq;
                bf16_t* base; if (row < TL) { const int t = row & (SEQ - 1); base = vtl + (size_t)(row >> 12) * DM * SEQ + (t >> 3) * 512 + (t & 7); } else { const int rr = row - TL, t = rr & (CTXL - 1); base = vtc + (size_t)(rr >> 8) * DM * CTXL + (t >> 3) * 512 + (t & 7); }
                const size_t ld = row < TL ? SEQ : CTXL;
#pragma unroll
                for (int bj = 0; bj < 2; ++bj)
#pragma unroll
                    for (int n = 0; n < 2; ++n) { const int vc = vc0 + bj * 128 + wc * 32 + 8 * (fr >> 2) + 4 * n + (fr & 3); const f32x4 v = acc[ai][bj][m][n];
                        u32x2 w; w.x = pk2(v[0], v[1]); w.y = pk2(v[2], v[3]); *(u32x2*)(base + (size_t)(vc >> 6) * 64 * ld + (vc & 63) * 8) = w; } }
    }
};
struct EpiBf16 {
    bf16_t* dst; int ldc, row0, col0; const float* bias; int gelu; LAS float* stg; int blk;
    EPI_NOPRE
    DEVFN void stage() const { const int t = TIDX; if (t < 64) *(LAS f32x4*)(stg + 4 * t) = *(const f32x4*)(bias + col0 + 4 * t); }
    DEVFN void operator()(const f32x4 (&acc)[2][2][4][2], int wr, int wc, int fr, int fq) const {
        f32x4 bv[2][2];
#pragma unroll
        for (int bj = 0; bj < 2; ++bj)
#pragma unroll
            for (int n = 0; n < 2; ++n) bv[bj][n] = *(const LAS f32x4*)(stg + bj * 128 + wc * 32 + 8 * fq + 4 * n);
#pragma unroll
        for (int ai = 0; ai < 2; ++ai)
#pragma unroll
            for (int m = 0; m < 4; ++m) { const int row = row0 + ai * 128 + wr * 64 + m * 16 + fr;
#pragma unroll
                for (int bj = 0; bj < 2; ++bj) { const int col = col0 + bj * 128 + wc * 32 + 8 * fq; f32x4 v0 = acc[ai][bj][m][0] + bv[bj][0], v1 = acc[ai][bj][m][1] + bv[bj][1];
                    if (gelu) { const f32x2 a = gelu_pk((f32x2){v0[0], v0[1]}), b = gelu_pk((f32x2){v0[2], v0[3]}), c = gelu_pk((f32x2){v1[0], v1[1]}), d = gelu_pk((f32x2){v1[2], v1[3]});
                        v0 = (f32x4){a.x, a.y, b.x, b.y}; v1 = (f32x4){c.x, c.y, d.x, d.y}; }
                    *(u32x4*)(dst + (blk ? blk_elem_k(row, col, ldc) : (size_t)row * ldc + col)) = pack8(v0, v1); } }
    }
};
struct EpiResid {
    bf16_t* X; const float* gate; const float* bias; int row0, col0; int dry;
    EPI_NOPRE
    DEVFN void operator()(const f32x4 (&acc)[2][2][4][2], int wr, int wc, int fr, int fq) const {
        const int mr = row0 < TL ? (row0 >> 12) : 8;
        f32x4 bv[2][2], gv[2][2];
#pragma unroll
        for (int bj = 0; bj < 2; ++bj)
#pragma unroll
            for (int n = 0; n < 2; ++n) { const int col = col0 + bj * 128 + wc * 32 + 8 * fq + 4 * n;
                bv[bj][n] = bias ? *(const f32x4*)(bias + col) : (f32x4){0.f, 0.f, 0.f, 0.f}; gv[bj][n] = *(const f32x4*)(gate + (size_t)mr * 6144 + col); }
#pragma unroll
        for (int ai = 0; ai < 2; ++ai)
#pragma unroll
            for (int m = 0; m < 4; ++m) { const int row = row0 + ai * 128 + wr * 64 + m * 16 + fr;
#pragma unroll
                for (int bj = 0; bj < 2; ++bj) { const int col = col0 + bj * 128 + wc * 32 + 8 * fq; u32x4* px = (u32x4*)(X + (size_t)row * DM + col); const u32x4 xo = *px;
                    const f32x4 n0 = (f32x4){bflo(xo.x), bfhi(xo.x), bflo(xo.y), bfhi(xo.y)} + gv[bj][0] * (acc[ai][bj][m][0] + bv[bj][0]);
                    const f32x4 n1 = (f32x4){bflo(xo.z), bfhi(xo.z), bflo(xo.w), bfhi(xo.w)} + gv[bj][1] * (acc[ai][bj][m][1] + bv[bj][1]);
                    if (!dry || n0[0] == 1.2345678e-33f) *px = pack8(n0, n1); } }
    }
};
struct EpiSwiglu {
    bf16_t* dst; int row0, cg0; const float* bgu; int dry;
    DEVFN BiasPre pre(int wc, int fq) const { BiasPre r;
#pragma unroll
        for (int n = 0; n < 2; ++n) { const int col = cg0 + wc * 32 + 8 * fq + 4 * n; r.b[0][n] = *(const f32x4*)(bgu + col); r.b[1][n] = *(const f32x4*)(bgu + 1024 + col) + 1.0f; }
        return r; }
    DEVFN void init(f32x4 (&acc)[2][2][4][2], const BiasPre& pre) const { acc_bias(acc, pre); }
    DEVFN void operator()(const f32x4 (&acc)[2][2][4][2], int wr, int wc, int fr, int fq) const {
#pragma unroll
        for (int ai = 0; ai < 2; ++ai)
#pragma unroll
            for (int m = 0; m < 4; ++m) { const int row = row0 + ai * 128 + wr * 64 + m * 16 + fr; f32x4 o[2];
#pragma unroll
                for (int n = 0; n < 2; ++n) { const f32x4 g = acc[ai][0][m][n], l = acc[ai][1][m][n];
#pragma unroll
                    for (int j = 0; j < 4; ++j) { const float xg = fminf(g[j], 7.0f), xl1 = fminf(fmaxf(l[j], -6.0f), 8.0f);
                        const float sg = __builtin_amdgcn_rcpf(1.0f + __builtin_amdgcn_exp2f(-1.702f * 1.44269504f * xg)); o[n][j] = xg * sg * xl1; } }
                const u32x4 w = pack8(o[0], o[1]); if (!dry || w.x == 0x12345u) *(u32x4*)(dst + blk_elem(row, cg0 + wc * 32 + 8 * fq)) = w; }
    }
};
struct EpiMoeDn {
    bf16_t* dst; int row0, col0; const float* bias; const float* gates; int cnt, rb, dry;
    DEVFN BiasPre pre(int wc, int fq) const { BiasPre r;
#pragma unroll
        for (int bj = 0; bj < 2; ++bj)
#pragma unroll
            for (int n = 0; n < 2; ++n) r.b[bj][n] = *(const f32x4*)(bias + col0 + bj * 128 + wc * 32 + 8 * fq + 4 * n);
        return r; }
    DEVFN void init(f32x4 (&acc)[2][2][4][2], const BiasPre& pre) const { acc_bias(acc, pre); }
    DEVFN void operator()(const f32x4 (&acc)[2][2][4][2], int wr, int wc, int fr, int fq) const {
#pragma unroll
        for (int ai = 0; ai < 2; ++ai)
#pragma unroll
            for (int m = 0; m < 4; ++m) { const int rl = ai * 128 + wr * 64 + m * 16 + fr; const int pos = rb * 256 + rl; const float gt = pos < cnt ? gates[pos] : 0.f;
#pragma unroll
                for (int bj = 0; bj < 2; ++bj) { const int col = col0 + bj * 128 + wc * 32 + 8 * fq;
                    const u32x4 w = pack8(acc[ai][bj][m][0] * gt, acc[ai][bj][m][1] * gt);
                    if (!dry || w.x == 0x12345u) *(u32x4*)(dst + (size_t)(row0 + rl) * DM + col) = w; } }
    }
};

struct EpiVtG {
    bf16_t* vt; float* stat; const float* bias; int row0, col0;
    EPI_NOPRE
    DEVFN void operator()(const f32x4 (&acc)[2][2][4][2], int wr, int wc, int fr, int fq) const {
#pragma unroll
        for (int bj = 0; bj < 2; ++bj) {
            const int tok0 = col0 + bj * 128, chunk = tok0 >> 7, q0 = wc * 32 + 8 * fq;
            float s[8], ss[8];
#pragma unroll
            for (int e = 0; e < 8; ++e) { s[e] = 0.f; ss[e] = 0.f; }
#pragma unroll
            for (int ai = 0; ai < 2; ++ai)
#pragma unroll
                for (int m = 0; m < 4; ++m) { const int ch = row0 + ai * 128 + wr * 64 + m * 16 + fr; const float bch = bias[ch];
                    f32x4 v0 = acc[ai][bj][m][0] + bch, v1 = acc[ai][bj][m][1] + bch;
                    { const f32x2 a = gelu_pk((f32x2){v0[0], v0[1]}), b = gelu_pk((f32x2){v0[2], v0[3]}), c = gelu_pk((f32x2){v1[0], v1[1]}), d = gelu_pk((f32x2){v1[2], v1[3]});
                      v0 = (f32x4){a.x, a.y, b.x, b.y}; v1 = (f32x4){c.x, c.y, d.x, d.y}; }
                    *(u32x4*)(vt + (size_t)chunk * 3072 * 128 + blk_elem_k(ch, q0, 128)) = pack8(v0, v1);
#pragma unroll
                    for (int j = 0; j < 4; ++j) { s[j] += v0[j]; ss[j] += v0[j] * v0[j]; s[4 + j] += v1[j]; ss[4 + j] += v1[j] * v1[j]; } }
#define RS8(n, x) { const bool hi = (fr & (x)) != 0; _Pragma("unroll") for (int k = 0; k < (n); ++k) { \
                const float g1 = hi ? s[k] : s[k + (n)], k1 = hi ? s[k + (n)] : s[k]; s[k] = k1 + __shfl_xor(g1, (x)); \
                const float g2 = hi ? ss[k] : ss[k + (n)], k2 = hi ? ss[k + (n)] : ss[k]; ss[k] = k2 + __shfl_xor(g2, (x)); } }
            RS8(4, 8) RS8(2, 4) RS8(1, 2)
#undef RS8
            const float ts = s[0] + __shfl_xor(s[0], 1), tss = ss[0] + __shfl_xor(ss[0], 1);
            const int e = ((fr >> 3) & 1) * 4 + ((fr >> 2) & 1) * 2 + ((fr >> 1) & 1);
            stat[((size_t)(tok0 + q0 + e) * 24 + (row0 >> 8) * 2 + wr) * 2 + (fr & 1)] = (fr & 1) ? tss : ts;
        }
    }
};

DEVFN size_t wblk_elem_k(int no, int k, int K) { const int rho = no & 31, pos = (no & ~31) + 16 * ((rho >> 2) & 1) + 4 * (rho >> 3) + (rho & 3); return ((size_t)(pos >> 4) * (K >> 3) + (k >> 3)) * 128 + (pos & 15) * 8; }
DEVFN void conv_unit(char* smem, const float* __restrict__ W, bf16_t* __restrict__ out, int K, int N, int unit, int blkrows) {
    float* tile = (float*)smem;
    const int tid = TIDX, nN = N >> 8, kt = unit / nN, nt = unit - kt * nN, k0 = kt * 64, n0 = nt * 256;
#pragma unroll
    for (int i = 0; i < 8; ++i) { const int idx = tid + 512 * i, r = idx >> 6, c4 = idx & 63;
        const f32x4 v = *(const f32x4*)(W + (size_t)(k0 + r) * N + n0 + 4 * c4); *(f32x4*)(tile + r * 260 + 4 * c4) = v; }
    __syncthreads();
    const int n = tid >> 1, kh = tid & 1;
    unsigned pk[16];
#pragma unroll
    for (int j = 0; j < 16; ++j) pk[j] = pk2(tile[(32 * kh + 2 * j) * 260 + n], tile[(32 * kh + 2 * j + 1) * 260 + n]);
    const int nn = n0 + n;
    if (n0 < blkrows) {
#pragma unroll
        for (int j = 0; j < 4; ++j) *(u32x4*)(out + wblk_elem_k(nn, k0 + 32 * kh + 8 * j, K)) = (u32x4){pk[4 * j], pk[4 * j + 1], pk[4 * j + 2], pk[4 * j + 3]};
    } else {
        u32x4* dst = (u32x4*)(out + (size_t)nn * K + k0 + 32 * kh);
#pragma unroll
        for (int j = 0; j < 4; ++j) dst[j] = (u32x4){pk[4 * j], pk[4 * j + 1], pk[4 * j + 2], pk[4 * j + 3]};
    }
    __syncthreads();
}
DEVFN size_t wblk_elem(int no, int k) { const int rho = no & 31, pos = (no & ~31) + 16 * ((rho >> 2) & 1) + 4 * (rho >> 3) + (rho & 3); return ((size_t)(pos >> 4) * 128 + (k >> 3)) * 128 + (pos & 15) * 8; }
template <int SH, int N, int PERM>
DEVFN void conv_stream(char* smem, const float* __restrict__ W0, bf16_t* __restrict__ out0, int nunits) {
    constexpr int K = 1024, nN = N >> 8;
    float* tile = (float*)smem;
    const int tid = TIDX, G = gridDim.x;
    f32x4 buf[8];
    int u = blockIdx.x;
    if (u < nunits) { const int le = u >> SH, unit = u & ((1 << SH) - 1), kt = unit / nN, nt = unit - kt * nN; const float* W = W0 + (size_t)le * K * N + (size_t)(kt * 64) * N + nt * 256;
#pragma unroll
        for (int i = 0; i < 8; ++i) { const int idx = tid + 512 * i, r = idx >> 6, c4 = idx & 63; buf[i] = *(const f32x4*)(W + (size_t)r * N + 4 * c4); } }
    while (u < nunits) {
#pragma unroll
        for (int i = 0; i < 8; ++i) { const int idx = tid + 512 * i, r = idx >> 6, c4 = idx & 63; *(f32x4*)(tile + r * 260 + 4 * c4) = buf[i]; }
        __syncthreads();
        const int un = u + G;
        if (un < nunits) { const int le = un >> SH, unit = un & ((1 << SH) - 1), kt = unit / nN, nt = unit - kt * nN; const float* W = W0 + (size_t)le * K * N + (size_t)(kt * 64) * N + nt * 256;
#pragma unroll
            for (int i = 0; i < 8; ++i) { const int idx = tid + 512 * i, r = idx >> 6, c4 = idx & 63; buf[i] = *(const f32x4*)(W + (size_t)r * N + 4 * c4); } }
        { const int le = u >> SH, unit = u & ((1 << SH) - 1), kt = unit / nN, nt = unit - kt * nN, k0 = kt * 64, n0 = nt * 256;
          const int n = tid >> 1, kh = tid & 1;
          unsigned pk[16];
#pragma unroll
          for (int j = 0; j < 16; ++j) pk[j] = pk2(tile[(32 * kh + 2 * j) * 260 + n], tile[(32 * kh + 2 * j + 1) * 260 + n]);
          const int nn = n0 + n;
          const int no = PERM ? ((nn < 1024) ? ((nn >> 7) * 256 + (nn & 127)) : ((((nn - 1024) >> 7) * 256) + 128 + (nn & 127))) : nn;
          bf16_t* dstm = out0 + (size_t)le * N * K;
#pragma unroll
          for (int j = 0; j < 4; ++j) *(u32x4*)(dstm + wblk_elem(no, k0 + 32 * kh + 8 * j)) = (u32x4){pk[4 * j], pk[4 * j + 1], pk[4 * j + 2], pk[4 * j + 3]}; }
        __syncthreads();
        u = un;
    }
}
constexpr int WQ_GU = 32 * 128, WQ_UNITS = WQ_GU + 32 * 64;
#ifndef FILL_IN
#define FILL_IN 6
#endif
#ifndef FILL_OUT
#define FILL_OUT 9
#endif
#ifndef FILL_OUT3
#define FILL_OUT3 26
#endif
#ifndef FILL_MOE
#define FILL_MOE 6
#endif
DEVFN void conv_range(const Params& p, char* smem, int l, int q0, int q1) {
    float* tile = (float*)smem;
    const int tid = TIDX;
    f32x4 buf[8];
#define CQ_DECODE(q_) const bool gu = (q_) < WQ_GU; const int rr = gu ? (q_) : (q_) - WQ_GU; const int N = gu ? 2048 : 1024; \
        const int le = l * 32 + (gu ? rr >> 7 : rr >> 6), unit = gu ? (rr & 127) : (rr & 63), kt = gu ? unit >> 3 : unit >> 2, nt = gu ? (unit & 7) : (unit & 3);
#define CQ_LOAD(q_) { CQ_DECODE(q_) const float* W = (gu ? p.moe_w_gu : p.moe_w_dn) + (size_t)le * 1024 * N + (size_t)(kt * 64) * N + nt * 256; \
        _Pragma("unroll") for (int i = 0; i < 8; ++i) { const int idx = tid + 512 * i, r = idx >> 6, c4 = idx & 63; buf[i] = *(const f32x4*)(W + (size_t)r * N + 4 * c4); } }
    int q = q0;
    if (q < q1) CQ_LOAD(q)
    while (q < q1) {
#pragma unroll
        for (int i = 0; i < 8; ++i) { const int idx = tid + 512 * i, r = idx >> 6, c4 = idx & 63; *(f32x4*)(tile + r * 260 + 4 * c4) = buf[i]; }
        __syncthreads();
        if (q + 1 < q1) CQ_LOAD(q + 1)
        { CQ_DECODE(q) const int k0 = kt * 64, n0 = nt * 256, n = tid >> 1, kh = tid & 1;
          unsigned pk[16];
#pragma unroll
          for (int j = 0; j < 16; ++j) pk[j] = pk2(tile[(32 * kh + 2 * j) * 260 + n], tile[(32 * kh + 2 * j + 1) * 260 + n]);
          const int nn = n0 + n;
          const int no = gu ? ((nn < 1024) ? ((nn >> 7) * 256 + (nn & 127)) : ((((nn - 1024) >> 7) * 256) + 128 + (nn & 127))) : nn;
          bf16_t* dstm = (gu ? p.MOEGU : p.MOEDN) + (size_t)le * N * 1024;
#pragma unroll
          for (int j = 0; j < 4; ++j) *(u32x4*)(dstm + wblk_elem(no, k0 + 32 * kh + 8 * j)) = (u32x4){pk[4 * j], pk[4 * j + 1], pk[4 * j + 2], pk[4 * j + 3]}; }
        __syncthreads();
        ++q;
    }
#undef CQ_DECODE
#undef CQ_LOAD
}
DEVFN void conv_fill(const Params& p, char* smem, int lmin, int budget) {
    if (lmin > 3 || budget <= 0) return;
    int* slot = (int*)(smem + 67584);
    __syncthreads();
    if (TIDX == 0) { int l = lmin, q0;
        for (;;) { q0 = __hip_atomic_fetch_add(p.cnt + 128 + l, budget, __ATOMIC_RELAXED, __HIP_MEMORY_SCOPE_AGENT); if (q0 < WQ_UNITS || l == 3) break; ++l; }
        slot[0] = q0; slot[1] = l; }
    __syncthreads();
    const int q0 = __builtin_amdgcn_readfirstlane(slot[0]), l = __builtin_amdgcn_readfirstlane(slot[1]);
    conv_range(p, smem, l, q0, min(q0 + budget, WQ_UNITS));
}
DEVFN void conv_drain(const Params& p, char* smem, int l) {
    int* slot = (int*)(smem + 67584);
    for (;;) {
        __syncthreads();
        if (TIDX == 0) slot[0] = __hip_atomic_fetch_add(p.cnt + 128 + l, 4, __ATOMIC_RELAXED, __HIP_MEMORY_SCOPE_AGENT);
        __syncthreads();
        const int q0 = __builtin_amdgcn_readfirstlane(slot[0]);
        if (q0 >= WQ_UNITS) break;
        conv_range(p, smem, l, q0, min(q0 + 4, WQ_UNITS));
    }
    __syncthreads();
}
DEVFN void mod_unit(char* smem, const Params& p, int unit) {
    float* s = (float*)smem;
    float* red = s + 9 * 1024;
    const int tid = TIDX, layer = unit / 48, cb = unit % 48, nl = tid & 127, n = cb * 128 + nl, kq = tid >> 7;
    for (int idx = tid; idx < 9 * 1024; idx += NTHREADS) { const int r = idx >> 10, k = idx & 1023; const float v = r < 8 ? p.c[r * 1024 + k] : p.c_ctx[k]; s[idx] = v / (1.0f + __expf(-v)); }
    __syncthreads();
    float acc[9];
#pragma unroll
    for (int r = 0; r < 9; ++r) acc[r] = 0.f;
    const float* w = p.ada_w + ((size_t)layer * 1024 + kq * 256) * 6144 + n;
#pragma unroll 16
    for (int k = 0; k < 256; ++k) { const float wv = w[(size_t)k * 6144];
#pragma unroll
        for (int r = 0; r < 9; ++r) acc[r] += s[r * 1024 + kq * 256 + k] * wv; }
#pragma unroll
    for (int r = 0; r < 9; ++r) red[(kq * 9 + r) * 128 + nl] = acc[r];
    __syncthreads();
    if (kq == 0) {
#pragma unroll
        for (int r = 0; r < 9; ++r) { const float v = ((red[r * 128 + nl] + red[(9 + r) * 128 + nl]) + (red[(18 + r) * 128 + nl] + red[(27 + r) * 128 + nl])) + p.ada_b[layer * 6144 + n];
            p.MOD[((size_t)layer * 9 + r) * 6144 + n] = v; }
    }
    __syncthreads();
}
DEVFN void hya_pos(const Params& p, int pg, int lane) {
    const int L = pg < SEQ ? SEQ : CTXL, pos = pg < SEQ ? pg : pg - SEQ;
    const float t = (float)pos / (float)(L - 1), w = 6.283185307179586f * (float)pos / (float)L;
    float z = 0.f;
    if (lane == 0) z = t;
    else if (lane <= 16) { const float f = 1e-4f + (float)(lane - 1) * ((15.0f - 1e-4f) / 15.0f); z = cosf(f * w); }
    else if (lane <= 32) { const float f = 1e-4f + (float)(lane - 17) * ((15.0f - 1e-4f) / 15.0f); z = -sinf(f * w); }
    const float fr = p.hy_f_freq[lane];
    float a = p.hy_f_b1[lane];
    for (int i = 0; i < 33; ++i) a += __shfl(z, i) * p.hy_f_w1[i * 64 + lane];
    a = sinf(fr * a);
    float a2 = p.hy_f_b2[lane];
    for (int i = 0; i < 64; ++i) a2 += __shfl(a, i) * p.hy_f_w2[i * 64 + lane];
    a2 = sinf(fr * a2);
    float a3 = p.hy_f_b3[lane];
    for (int i = 0; i < 64; ++i) a3 += __shfl(a2, i) * p.hy_f_w3[i * 64 + lane];
    a3 = sinf(fr * a3);
    p.FA[(size_t)pg * 64 + lane] = a3;
}
DEVFN void phase_p0(const Params& p, char* smem) {
    const int G = gridDim.x, bid = blockIdx.x, tid = TIDX;
    if (bid == 0 && tid < 144) p.cnt[tid] = 0;
    for (int u = bid; u < 192; u += G) mod_unit(smem, p, u);
    for (int pg = bid * 8 + (tid >> 6); pg < SEQ + CTXL; pg += G * 8) hya_pos(p, pg, tid & 63);
    for (int u = bid; u < 2 * 192; u += G) { const int j = u / 192; conv_unit(smem, p.na_w_qkv + (size_t)j * 1024 * 3072, p.WQKV + (size_t)j * 3072 * 1024, 1024, 3072, u % 192, 3072); }
    for (int u = bid; u < 2 * 64; u += G) { const int j = u / 64; conv_unit(smem, p.na_w_o + (size_t)j * 1024 * 1024, p.WO + (size_t)j * 1024 * 1024, 1024, 1024, u % 64, 1024); }
    for (int u = bid; u < 192; u += G) conv_unit(smem, p.hy_w_in, p.HYIN, 1024, 3072, u, 3072);
    for (int u = bid; u < 64; u += G) conv_unit(smem, p.hy_w_out, p.HYOUT, 1024, 1024, u, 1024);
    for (int u = bid; u < 384; u += G) conv_unit(smem, p.gm_w_in, p.GMIN, 1024, 6144, u, 3072);
    for (int u = bid; u < 192; u += G) conv_unit(smem, p.gm_w_out, p.GMOUT, 3072, 1024, u, 1024);
    for (int i = bid * NTHREADS + tid; i < 16 * 128 * 128 / 2; i += G * NTHREADS) { const f32x2 v = *(const f32x2*)(p.gm_w_s + 2 * (size_t)i); ((unsigned*)p.GMWS)[i] = pk2(v.x, v.y); }
    for (int i = bid * NTHREADS + tid; i < 16 * 128; i += G * NTHREADS) { const f32x4* w = (const f32x4*)(p.gm_w_s + (size_t)i * 128); float s = 0.f;
#pragma unroll 4
        for (int k = 0; k < 32; ++k) { const f32x4 v = w[k]; s += (v[0] + v[1]) + (v[2] + v[3]); }
        p.GMS0[i] = s; }
    conv_stream<7, 2048, 1>(smem, p.moe_w_gu, p.MOEGU, 32 * 128);
    conv_stream<6, 1024, 0>(smem, p.moe_w_dn, p.MOEDN, 32 * 64);
}

DEVFN void norm_mod_store(const f32x4 (&v)[4], const float* __restrict__ g, const float* __restrict__ sh, const float* __restrict__ sc, bf16_t* __restrict__ orow, int lane, f32x4 (&h)[4]) {
    float ss = 0.f;
#pragma unroll
    for (int i = 0; i < 4; ++i) ss += (v[i][0] * v[i][0] + v[i][1] * v[i][1]) + (v[i][2] * v[i][2] + v[i][3] * v[i][3]);
    const float r = rsqrtf(wave_sum(ss) * (1.0f / DM) + 1e-6f);
#pragma unroll
    for (int i = 0; i < 4; ++i) { const int c = 4 * lane + 256 * i; const f32x4 gv = *(const f32x4*)(g + c), s1 = *(const f32x4*)(sh + c), s2 = *(const f32x4*)(sc + c);
        h[i] = (v[i] * r * gv) * (s2 + 1.0f) + s1;
        u32x2 w; w.x = pk2(h[i][0], h[i][1]); w.y = pk2(h[i][2], h[i][3]); *(u32x2*)(orow + c) = w; }
}
DEVFN void phase_n1_first(const Params& p) {
    const int lane = TIDX & 63, gw = blockIdx.x * 8 + (TIDX >> 6), NW = gridDim.x * 8;
    for (int tok = gw; tok < TT; tok += NW) {
        const float* src = tok < TL ? p.x + (size_t)tok * DM : p.ctx + (size_t)(tok - TL) * DM; const int mr = tok < TL ? (tok >> 12) : 8;
        f32x4 v[4], h[4];
#pragma unroll
        for (int i = 0; i < 4; ++i) { v[i] = *(const f32x4*)(src + 4 * lane + 256 * i); u32x2 w; w.x = pk2(v[i][0], v[i][1]); w.y = pk2(v[i][2], v[i][3]); *(u32x2*)(p.X + (size_t)tok * DM + 4 * lane + 256 * i) = w; }
        const float* mod = p.MOD + (size_t)mr * 6144;
        norm_mod_store(v, p.norm1_g, mod, mod + 1024, p.HX + (size_t)tok * DM, lane, h);
    }
}
template <int L>
DEVFN void hyb_unit(const Params& p, char* smem, int unit) {
    float* wl = (float*)smem;
    float* red = wl + 512;
    float* nrm = red + 32;
    bf16_t* rkl = (bf16_t*)(smem + 4096);
    const int tid = TIDX, d0 = unit * 4, posbase = (L == SEQ) ? 0 : SEQ;
    { const int i = tid >> 3, q = tid & 7; wl[tid] = p.hy_f_wout[(size_t)i * 2048 + (q < 4 ? d0 + q : 1024 + d0 + q - 4)]; }
    if (L == SEQ && tid < 4) rkl[tid * 8192 + 8191] = 0;
    __syncthreads();
    const float dlo = logf(0.3f) / 0.01f, dhi = logf(1.5f) / 0.01f;
    float ad[4];
#pragma unroll
    for (int cc = 0; cc < 4; ++cc) ad[cc] = fabsf(dlo + (float)(d0 + cc) * ((dhi - dlo) / 1023.0f));
    for (int pass = 0; pass < 2; ++pass) {
        float asum[4] = {0.f, 0.f, 0.f, 0.f}, inv[4];
#pragma unroll
        for (int cc = 0; cc < 4; ++cc) inv[cc] = pass ? 1.0f / nrm[cc] : 0.f;
#pragma unroll 1
        for (int t = tid; t < L; t += NTHREADS) {
            const f32x4* fa = (const f32x4*)(p.FA + (size_t)(posbase + t) * 64);
            f32x4 hf = (f32x4){0.f, 0.f, 0.f, 0.f}, hb = hf;
            int woff = 0; asm volatile("" : "+v"(woff));
            const float* wlp = wl + woff;
#pragma unroll 2
            for (int i4 = 0; i4 < 16; ++i4) { const f32x4 a = fa[i4];
#pragma unroll
                for (int j = 0; j < 4; ++j) { const f32x4 w0 = *(const f32x4*)(wlp + (4 * i4 + j) * 8), w1 = *(const f32x4*)(wlp + (4 * i4 + j) * 8 + 4); hf += w0 * a[j]; hb += w1 * a[j]; } }
            const float tn = (float)t / (float)(L - 1);
#pragma unroll
            for (int cc = 0; cc < 4; ++cc) { const float dec = expf(-tn * ad[cc]); const float f = hf[cc] * dec, bk = hb[cc] * dec;
                if (pass == 0) asum[cc] += (t == 0) ? fabsf(f + bk) : (fabsf(f) + fabsf(bk));
                else if (L == SEQ) {
                    bf16_t* row = rkl + cc * 8192;
                    if (t == 0) row[4095] = (bf16_t)(pk2((f + bk) * inv[cc], 0.f) & 0xffff);
                    else { const unsigned w = pk2(f * inv[cc], bk * inv[cc]); row[4095 - t] = (bf16_t)(w & 0xffff); row[4095 + t] = (bf16_t)(w >> 16); }
                } else {
                    float* row = p.KC + (size_t)(d0 + cc) * (2 * L);
                    if (t == 0) { row[L] = (f + bk) * inv[cc]; row[0] = 0.f; } else { row[L + t] = f * inv[cc]; row[L - t] = bk * inv[cc]; }
                } }
        }
        if (pass == 0) {
#pragma unroll
            for (int cc = 0; cc < 4; ++cc) { const float s = wave_sum(asum[cc]); if ((tid & 63) == 0) red[(tid >> 6) * 4 + cc] = s; }
            __syncthreads();
            if (tid < 4) { float s = 0.f; for (int w = 0; w < 8; ++w) s += red[w * 4 + tid]; nrm[tid] = s; }
            __syncthreads();
        }
    }
    __syncthreads();
    if (L == SEQ) {
#pragma unroll 1
        for (int it = tid; it < 16384; it += NTHREADS) { const int w8 = it & 1023, sg = (it >> 10) & 3, cc = it >> 12; const bf16_t* row = rkl + cc * 8192; const int u = 8 * w8 + sg;
            unsigned short e[8];
#pragma unroll
            for (int k = 0; k < 8; ++k) e[k] = (u + k < 8192) ? row[u + k] : (unsigned short)0;
            u32x4 o; o.x = e[0] | ((unsigned)e[1] << 16); o.y = e[2] | ((unsigned)e[3] << 16); o.z = e[4] | ((unsigned)e[5] << 16); o.w = e[6] | ((unsigned)e[7] << 16);
            *(u32x4*)(p.RK4 + ((size_t)(d0 + cc) * 4 + sg) * 8192 + 8 * w8) = o; }
        __syncthreads();
    }
}

template <bool LOCAL, int MODE = 0>
DEVFN void attn_unit(const bf16_t* __restrict__ Q, const bf16_t* __restrict__ Kb, const bf16_t* __restrict__ VtL, const bf16_t* __restrict__ VtC, bf16_t* __restrict__ O,
                     const LAS float* bias, LAS unsigned char* qlds, int b, int R, int h, int jb, int lane) {
    constexpr int NL = LOCAL ? 11 : 0, NG = NL + 8, PD = 1;
    constexpr float L2E = 1.44269504f;
    const int q = lane & 15, g = lane >> 4;
    const int W0 = LOCAL ? min(max(R - 4, 0), 53) : 0, bs = LOCAL ? min(max(16 * jb - 8, 0), 32) : 0;
    int qtok[4];
#pragma unroll
    for (int i = 0; i < 4; ++i) qtok[i] = LOCAL ? (b * SEQ + (R + i) * 64 + 16 * jb) : (TL + b * CTXL + 16 * (4 * jb + i));
    { bf16x8 qt[4][2];
#pragma unroll
      for (int i = 0; i < 4; ++i)
#pragma unroll
        for (int kk = 0; kk < 2; ++kk) qt[i][kk] = *(const bf16x8*)(Q + blk_elem_k(qtok[i] + q, h * 64 + 32 * kk + 8 * g, DM));
#pragma unroll
      for (int i = 0; i < 4; ++i)
#pragma unroll
        for (int kk = 0; kk < 2; ++kk) *(LAS bf16x8*)(qlds + (i * 2 + kk) * 1024 + lane * 16) = qt[i][kk]; }
    const int c1 = 8 * (q >> 2) + (q & 3);
    (void)c1;
    const unsigned koff = (unsigned)(((q >> 2) * 128 + g) * 64 + (q & 3) * 8) * 2u, koff2 = koff + 64u, voffL = (unsigned)(g * 512 + q * 8) * 2u, voffC = voffL;
    float addm[8]; int dcl[8];
#pragma unroll
    for (int e = 0; e < 8; ++e) { addm[e] = 0.f; dcl[e] = 0; }
    if (LOCAL) { const int qc = 16 * jb + q, ws = min(max(qc - 8, 0), 48), dc0 = bs + 8 * g - qc + 15;
#pragma unroll
        for (int e = 0; e < 8; ++e) { const int kc = bs + 8 * g + e; addm[e] = (kc >= ws && kc < ws + 16) ? 0.f : -3e38f; dcl[e] = min(max(dc0 + e, 0), 30); } }
    unsigned one2 = 0x3f803f80u; asm volatile("" : "+v"(one2));
    union { bf16x8 v; unsigned u[4]; } ones; ones.u[0] = ones.u[1] = ones.u[2] = ones.u[3] = one2;
    f32x4 osum[4];
#pragma unroll
    for (int i = 0; i < 4; ++i) osum[i] = (f32x4){0.f, 0.f, 0.f, 0.f};
    f32x4 o[4][4]; float mref[4];
#pragma unroll
    for (int i = 0; i < 4; ++i) { mref[i] = -1e30f;
#pragma unroll
        for (int mt = 0; mt < 4; ++mt) o[i][mt] = (f32x4){0.f, 0.f, 0.f, 0.f}; }
    bf16x8 kfc[4], kfn[4], vf[4];
#define ATTN_KBASE(G) ((const char*)(Kb + (size_t)((LOCAL && (G) < NL) ? (b * SEQ + (W0 + (G)) * 64 + bs) : (TL + b * CTXL + 32 * ((G) - NL))) * DM + h * 512))
#define ATTN_LOADK(dst, G) do { const char* kb_ = ATTN_KBASE(G); dst[0] = *(const bf16x8*)(kb_ + koff); dst[1] = *(const bf16x8*)(kb_ + koff + 512); dst[2] = *(const bf16x8*)(kb_ + koff2); dst[3] = *(const bf16x8*)(kb_ + koff2 + 512); } while (0)
    ATTN_LOADK(kfc, 0);
    unsigned dummy = 0;
    if (MODE == 2) { const char* vb0 = (const char*)(VtC + (size_t)(b * DM + h * 64) * CTXL);
#pragma unroll
        for (int mt = 0; mt < 4; ++mt) vf[mt] = *(const bf16x8*)(vb0 + voffC + (size_t)mt * 256); }
#pragma unroll 1
    for (int gi = 0; gi < NG; ++gi) {
        const bool locg = LOCAL && gi < NL;
        if (MODE != 2) { const char* vbase = locg ? (const char*)(VtL + (size_t)(b * DM + h * 64) * SEQ + ((W0 + gi) * 64 + bs) * 64) : (const char*)(VtC + (size_t)(b * DM + h * 64) * CTXL + 32 * (gi - NL) * 64);
          const unsigned vo = voffL; const size_t vst = 256;
#pragma unroll
          for (int mt = 0; mt < 4; ++mt) vf[mt] = *(const bf16x8*)(vbase + vo + mt * vst); }
        if (MODE != 2) { const int gn = gi + 1 < NG ? gi + 1 : gi; ATTN_LOADK(kfn, gn); }
        asm volatile("" ::: "memory");
        if (MODE == 1) {
#pragma unroll
            for (int k = 0; k < 4; ++k) { union { bf16x8 v; unsigned u[4]; } a, c; a.v = kfc[k]; c.v = vf[k]; dummy ^= (a.u[0] ^ a.u[1]) ^ (a.u[2] ^ a.u[3]) ^ (c.u[0] ^ c.u[1]) ^ (c.u[2] ^ c.u[3]); }
        }
#pragma unroll
        for (int i = 0; i < 4 && MODE != 1; ++i) {
            int drow = 0; bool act = true;
            if (locg) { const int r = R + i, r0 = min(max(r - 4, 0), 56), wr = W0 + gi; act = (wr >= r0) && (wr < r0 + 8); drow = wr - r + 7; }
            if (act) {
                const f32x4 z = (f32x4){0.f, 0.f, 0.f, 0.f};
                const bf16x8 q0_ = *(const LAS bf16x8*)(qlds + (i * 2) * 1024 + lane * 16), q1_ = *(const LAS bf16x8*)(qlds + (i * 2 + 1) * 1024 + lane * 16);
                f32x4 s0 = __builtin_amdgcn_mfma_f32_16x16x32_bf16(kfc[0], q0_, z, 0, 0, 0); s0 = __builtin_amdgcn_mfma_f32_16x16x32_bf16(kfc[1], q1_, s0, 0, 0, 0);
                f32x4 s1 = __builtin_amdgcn_mfma_f32_16x16x32_bf16(kfc[2], q0_, z, 0, 0, 0); s1 = __builtin_amdgcn_mfma_f32_16x16x32_bf16(kfc[3], q1_, s1, 0, 0, 0);
                float sv[8] = {s0[0], s0[1], s0[2], s0[3], s1[0], s1[1], s1[2], s1[3]};
                if (locg) { const LAS float* bp = bias + (h * 15 + drow) * 31;
#pragma unroll
                    for (int e = 0; e < 8; ++e) sv[e] = (sv[e] + bp[dcl[e]]) + addm[e]; }
                float lm = fmaxf(fmaxf(fmaxf(sv[0], sv[1]), fmaxf(sv[2], sv[3])), fmaxf(fmaxf(sv[4], sv[5]), fmaxf(sv[6], sv[7])));
                if (__any(lm > mref[i] + 40.0f)) {
                    lm = fmaxf(lm, __shfl_xor(lm, 16)); lm = fmaxf(lm, __shfl_xor(lm, 32)); const float mn = fmaxf(mref[i], lm), f = __builtin_amdgcn_exp2f(mref[i] - mn);
#pragma unroll
                    for (int mt = 0; mt < 4; ++mt) o[i][mt] = o[i][mt] * f;
                    osum[i] = osum[i] * f; mref[i] = mn; }
                float pv[8];
#pragma unroll
                for (int e = 0; e < 8; ++e) pv[e] = __builtin_amdgcn_exp2f(sv[e] - mref[i]);
                union { bf16x8 v; unsigned u[4]; } pf;
                pf.u[0] = pk2(pv[0], pv[1]); pf.u[1] = pk2(pv[2], pv[3]); pf.u[2] = pk2(pv[4], pv[5]); pf.u[3] = pk2(pv[6], pv[7]);
#pragma unroll
                for (int mt = 0; mt < 4; ++mt) o[i][mt] = __builtin_amdgcn_mfma_f32_16x16x32_bf16(vf[mt], pf.v, o[i][mt], 0, 0, 0);
                osum[i] = __builtin_amdgcn_mfma_f32_16x16x32_bf16(ones.v, pf.v, osum[i], 0, 0, 0);
            }
        }
        if (MODE != 2) {
#pragma unroll
            for (int k = 0; k < 4; ++k) kfc[k] = kfn[k]; }
    }
#undef ATTN_KBASE
#undef ATTN_LOADK
#pragma unroll
    for (int i = 0; i < 4; ++i) {
        const float inv = 1.0f / osum[i][0];
#pragma unroll
        for (int mt = 0; mt < 4; ++mt) { const f32x4 v = o[i][mt] * inv; u32x2 w; w.x = pk2(v[0], v[1]); w.y = pk2(v[2], v[3]);
            if (MODE == 0 || (w.x ^ dummy) == 0x12345u) *(u32x2*)(O + blk_elem_k(qtok[i] + q, h * 64 + 16 * mt + 4 * g, DM)) = w; }
    }
}
DEVFN void phase_attn(const Params& p, char* smem, int j, bool need_ctx) {
    const bf16_t* Q = (const bf16_t*)(p.BIG + NA_Q); const bf16_t* Kb = (const bf16_t*)(p.BIG + NA_K);
    const bf16_t* VtL = (const bf16_t*)(p.BIG + NA_VTL); const bf16_t* VtC = (const bf16_t*)(p.BIG + NA_VTC); bf16_t* O = (bf16_t*)(p.BIG + NA_O);
    const float* rpb = p.na_rpb + (size_t)j * 16 * 15 * 31;
    const int tid = TIDX, lane = tid & 63, wv = __builtin_amdgcn_readfirstlane(tid >> 6), gw = blockIdx.x * 8 + wv, NW = gridDim.x * 8;
    LAS float* bias = (LAS float*)smem; LAS unsigned char* qlds = (LAS unsigned char*)smem + 32768 + wv * 8192;
    __syncthreads();
    for (int i = tid; i < 16 * 15 * 31; i += NTHREADS) bias[i] = rpb[i] * 1.44269504f;
    __syncthreads();
    for (int u = gw; u < NB * 16 * 64; u += NW) { const int jb = u & 3, h = (u >> 2) & 15, bq = u >> 6; attn_unit<true>(Q, Kb, VtL, VtC, O, bias, qlds, bq >> 4, (bq & 15) * 4, h, jb, lane); }
    if (need_ctx) for (int u = gw; u < NB * 16 * 4; u += NW) { const int jb = u & 3, h = (u >> 2) & 15, b = u >> 6; attn_unit<false>(Q, Kb, VtL, VtC, O, bias, qlds, b, 0, h, jb, lane); }
#if ATTN_PROBE
    for (int u = gw; u < NB * 16 * 64; u += NW) { const int jb = u & 3, h = (u >> 2) & 15, bq = u >> 6; attn_unit<true, ATTN_PROBE>(Q, Kb, VtL, VtC, O, bias, qlds, bq >> 4, (bq & 15) * 4, h, jb, lane); }
#endif
    __syncthreads();
}

DEVFN void hy_gate_unit(const Params& p, char* smem, int R0, int t0, int L, int d0, bf16_t* vxt_row0  ) {
    bf16_t* tile = (bf16_t*)smem;
    const LAS float* wlds = (const LAS float*)(smem + 40960);
    const bf16_t* U = (const bf16_t*)(p.BIG + HY_U); bf16_t* X0 = (bf16_t*)(p.BIG + HY_X0);
    const int tid = TIDX, tt = tid & 63, dd8 = tid >> 6, t = t0 + tt;
    u32x4 uu[4][3][3];
#pragma unroll
    for (int j = 0; j < 3; ++j) { const int ts = t + j - 1; const bool ok = ts >= 0 && ts < L; const int urow = R0 + tt + (ok ? j - 1 : 0);
#pragma unroll
        for (int sub = 0; sub < 4; ++sub)
#pragma unroll
            for (int sec = 0; sec < 3; ++sec) { const u32x4 v = *(const u32x4*)(U + blk_elem_k(urow, sec * 1024 + d0 + 64 * sub + 8 * dd8, 3072)); uu[sub][sec][j] = ok ? v : (u32x4){0u, 0u, 0u, 0u}; } }
#pragma unroll
    for (int sub = 0; sub < 4; ++sub) {
        const int dch = d0 + 64 * sub + 8 * dd8;
        float y[3][8];
#pragma unroll
        for (int sec = 0; sec < 3; ++sec) {
            const int c = sec * 1024 + dch;
            const f32x4 cb0 = *(const LAS f32x4*)(wlds + 3 * 3072 + c), cb1 = *(const LAS f32x4*)(wlds + 3 * 3072 + c + 4);
#pragma unroll
            for (int e = 0; e < 4; ++e) { y[sec][e] = cb0[e]; y[sec][4 + e] = cb1[e]; }
#pragma unroll
            for (int j = 0; j < 3; ++j) { const u32x4 u = uu[sub][sec][j];
                const f32x4 w0 = *(const LAS f32x4*)(wlds + j * 3072 + c), w1 = *(const LAS f32x4*)(wlds + j * 3072 + c + 4);
                y[sec][0] += w0[0] * bflo(u.x); y[sec][1] += w0[1] * bfhi(u.x); y[sec][2] += w0[2] * bflo(u.y); y[sec][3] += w0[3] * bfhi(u.y);
                y[sec][4] += w1[0] * bflo(u.z); y[sec][5] += w1[1] * bfhi(u.z); y[sec][6] += w1[2] * bflo(u.w); y[sec][7] += w1[3] * bfhi(u.w); }
        }
        { u32x4 w; w.x = pk2(y[0][0], y[0][1]); w.y = pk2(y[0][2], y[0][3]); w.z = pk2(y[0][4], y[0][5]); w.w = pk2(y[0][6], y[0][7]); *(u32x4*)(X0 + blk_elem_k(R0 + tt, dch, DM)) = w; }
#pragma unroll
        for (int e = 0; e < 8; e += 2) { const unsigned w = pk2(y[2][e] * y[1][e], y[2][e + 1] * y[1][e + 1]); tile[(64 * sub + 8 * dd8 + e) * 72 + tt] = (bf16_t)(w & 0xffff); tile[(64 * sub + 8 * dd8 + e + 1) * 72 + tt] = (bf16_t)(w >> 16); }
    }
    __syncthreads();
#pragma unroll
    for (int sub = 0; sub < 4; ++sub) { const int dd = 64 * sub + (tid >> 3), ts = tid & 7; const u32x4 w = *(const u32x4*)(tile + dd * 72 + 8 * ts); *(u32x4*)(vxt_row0 + (size_t)(d0 + dd) * L + t0 + 8 * ts) = w; }
    __syncthreads();
}
DEVFN void phase_hy_gate(const Params& p, char* smem) {
    { LAS float* wl = (LAS float*)(smem + 40960); const int tid = TIDX; __syncthreads();
      for (int i = tid; i < 3 * 768; i += NTHREADS) *(LAS f32x4*)(wl + 4 * i) = *(const f32x4*)(p.hy_conv_w + 4 * i);
      for (int i = tid; i < 768; i += NTHREADS) *(LAS f32x4*)(wl + 3 * 3072 + 4 * i) = *(const f32x4*)(p.hy_conv_b + 4 * i);
      __syncthreads(); }
    for (int u = blockIdx.x; u < 2048 + 128; u += gridDim.x) {
        if (u < 2048) { const int dt = u & 3, tt = (u >> 2) & 63, b = u >> 8; hy_gate_unit(p, smem, b * SEQ + tt * 64, tt * 64, SEQ, dt * 256, (bf16_t*)(p.BIG + HY_VXTL) + (size_t)b * DM * SEQ); }
        else { const int v = u - 2048, dt = v & 3, tt = (v >> 2) & 3, b = v >> 4; hy_gate_unit(p, smem, TL + b * CTXL + tt * 64, tt * 64, CTXL, dt * 256, (bf16_t*)(p.BIG + HY_VXTC) + (size_t)b * DM * CTXL); }
    }
}
template <int L>
DEVFN void hy_conv_unit(const Params& p, char* smem, int d) {
    constexpr int NI = (L >= NTHREADS) ? L / NTHREADS : 1;
    float* kk = (float*)smem;
    bf16_t* vs = (bf16_t*)(smem + 2 * L * 4);
    const float* ksrc = p.KC + (size_t)d * 2 * L;
    const bf16_t* vxt = (const bf16_t*)(p.BIG + (L == SEQ ? HY_VXTL : HY_VXTC)); bf16_t* yt = (bf16_t*)(p.BIG + (L == SEQ ? HY_YTL : HY_YTC));
    const int tid = TIDX;
    for (int i = tid; i < 2 * L; i += NTHREADS) kk[i] = ksrc[i];
    for (int i = tid; i < L; i += NTHREADS) { const int b = i / (L / 8), t8 = i % (L / 8);
        const u32x4 w = *(const u32x4*)(vxt + ((size_t)b * DM + d) * L + 8 * t8);
        bf16_t* dv = vs + (size_t)(8 * t8) * 8 + b;
        dv[0] = (bf16_t)(w.x & 0xffff); dv[8] = (bf16_t)(w.x >> 16); dv[16] = (bf16_t)(w.y & 0xffff); dv[24] = (bf16_t)(w.y >> 16);
        dv[32] = (bf16_t)(w.z & 0xffff); dv[40] = (bf16_t)(w.z >> 16); dv[48] = (bf16_t)(w.w & 0xffff); dv[56] = (bf16_t)(w.w >> 16); }
    __syncthreads();
    if (tid < L) {
        float acc[NI][8];
#pragma unroll
        for (int i = 0; i < NI; ++i)
#pragma unroll
            for (int b = 0; b < 8; ++b) acc[i][b] = 0.f;
        for (int s = 0; s < L; ++s) {
            const u32x4 w = *(const u32x4*)(vs + (size_t)s * 8);
            const float v0 = bflo(w.x), v1 = bfhi(w.x), v2 = bflo(w.y), v3 = bfhi(w.y), v4 = bflo(w.z), v5 = bfhi(w.z), v6 = bflo(w.w), v7 = bfhi(w.w);
#pragma unroll
            for (int i = 0; i < NI; ++i) { const float kv = kk[tid + NTHREADS * i - s + L];
                acc[i][0] += kv * v0; acc[i][1] += kv * v1; acc[i][2] += kv * v2; acc[i][3] += kv * v3; acc[i][4] += kv * v4; acc[i][5] += kv * v5; acc[i][6] += kv * v6; acc[i][7] += kv * v7; }
        }
#pragma unroll
        for (int i = 0; i < NI; ++i)
#pragma unroll
            for (int b = 0; b < 8; ++b) yt[((size_t)b * DM + d) * L + tid + NTHREADS * i] = (bf16_t)(pk2(acc[i][b], 0.f) & 0xffff);
    }
    __syncthreads();
}
DEVFN void hy_convmm_unit(const Params& p, char* smem, int d) {
    constexpr int VROW = 10000, ROFF = 8 * VROW;
    LAS unsigned char* lds = (LAS unsigned char*)smem;
    const int tid = TIDX;
    { const u32x4* src = (const u32x4*)(p.RK4 + (size_t)d * 4 * 8192);
#pragma unroll
      for (int i = 0; i < 8; ++i) { const int idx = tid + NTHREADS * i; *(LAS u32x4*)(lds + ROFF + idx * 16) = src[idx]; }
      const bf16_t* vxt = (const bf16_t*)(p.BIG + HY_VXTL);
#pragma unroll
      for (int i = 0; i < 8; ++i) { const int idx = tid + NTHREADS * i, b = idx >> 9, ch = idx & 511; *(LAS u32x4*)(lds + b * VROW + 896 + ch * 16) = *(const u32x4*)(vxt + ((size_t)b * DM + d) * SEQ + 8 * ch); }
      for (int idx = tid; idx < 896; idx += NTHREADS) { const int b = idx / 112, k = idx % 112; *(LAS u32x4*)(lds + b * VROW + (k < 56 ? k * 16 : 896 + 8192 + (k - 56) * 16)) = (u32x4){0u, 0u, 0u, 0u}; } }
    __syncthreads();
    const int lane = tid & 63, w = __builtin_amdgcn_readfirstlane(tid >> 6), fr = lane & 15, fq = lane >> 4, sg = (3 - fr) & 3;
    const unsigned abase = (unsigned)(ROFF + sg * 16384 + (3647 - 512 * w - fr + 8 * fq - sg) * 2 - 96);
    const unsigned vbase = (unsigned)((fr & 7) * VROW + (64 * (fr >> 3) + 8 * fq) * 2);
    f32x4 acc[4][4];
#pragma unroll
    for (int it = 0; it < 4; ++it)
#pragma unroll
        for (int nt = 0; nt < 4; ++nt) acc[it][nt] = (f32x4){0.f, 0.f, 0.f, 0.f};
#pragma unroll 2
    for (int mm = 0; mm < 71; ++mm) {
        union { bf16x8 v; u32x2 h[2]; } af[6];
#pragma unroll
        for (int k = 0; k < 6; ++k) { const LAS unsigned char* a = lds + abase + mm * 128 + 160 - 32 * k; af[k].h[0] = *(const LAS u32x2*)a; af[k].h[1] = *(const LAS u32x2*)(a + 8); }
        bf16x8 bf[4][2];
#pragma unroll
        for (int nt = 0; nt < 4; ++nt)
#pragma unroll
            for (int jh = 0; jh < 2; ++jh) bf[nt][jh] = *(const LAS bf16x8*)(lds + vbase + mm * 128 + 256 * nt + 64 * jh);
#pragma unroll
        for (int jh = 0; jh < 2; ++jh)
#pragma unroll
            for (int it = 0; it < 4; ++it)
#pragma unroll
                for (int nt = 0; nt < 4; ++nt) acc[it][nt] = __builtin_amdgcn_mfma_f32_16x16x32_bf16(af[it - 2 * jh + 2].v, bf[nt][jh], acc[it][nt], 0, 0, 0);
    }
    bf16_t* yt = (bf16_t*)(p.BIG + HY_YTL) + ((size_t)(fr & 7) * DM + d) * SEQ;
#pragma unroll
    for (int it = 0; it < 4; ++it)
#pragma unroll
        for (int nt = 0; nt < 4; ++nt) { const int a = 8 * w + 2 * nt + (fr >> 3); u32x2 o; o.x = pk2(acc[it][nt][0], acc[it][nt][1]); o.y = pk2(acc[it][nt][2], acc[it][nt][3]);
            *(u32x2*)(yt + 64 * a + 16 * it + 4 * fq) = o; }
    __syncthreads();
}
DEVFN void hy_post_unit(const Params& p, char* smem, int R0, int t0, int L, int d0, const bf16_t* yt0, const bf16_t* vxt0) {
    bf16_t* tile = (bf16_t*)smem;
    const bf16_t* X0 = (const bf16_t*)(p.BIG + HY_X0); bf16_t* YB = (bf16_t*)(p.BIG + HY_YB);
    const int tid = TIDX;
    { const int ts = tid & 7; u32x4 a[4], v[4];
#pragma unroll
      for (int sub = 0; sub < 4; ++sub) { const int dd = 64 * sub + (tid >> 3); const size_t o = (size_t)(d0 + dd) * L + t0 + 8 * ts; a[sub] = *(const u32x4*)(yt0 + o); v[sub] = *(const u32x4*)(vxt0 + o); }
#pragma unroll
      for (int sub = 0; sub < 4; ++sub) { const int dd = 64 * sub + (tid >> 3); const float sk = p.hy_skip[d0 + dd];
        u32x4 w; w.x = pk2(bflo(a[sub].x) + bflo(v[sub].x) * sk, bfhi(a[sub].x) + bfhi(v[sub].x) * sk); w.y = pk2(bflo(a[sub].y) + bflo(v[sub].y) * sk, bfhi(a[sub].y) + bfhi(v[sub].y) * sk);
        w.z = pk2(bflo(a[sub].z) + bflo(v[sub].z) * sk, bfhi(a[sub].z) + bfhi(v[sub].z) * sk); w.w = pk2(bflo(a[sub].w) + bflo(v[sub].w) * sk, bfhi(a[sub].w) + bfhi(v[sub].w) * sk);
        *(u32x4*)(tile + dd * 72 + 8 * ts) = w; } }
    __syncthreads();
    { const int tt = tid & 63, dd8 = tid >> 6; u32x4 x0[4];
#pragma unroll
      for (int sub = 0; sub < 4; ++sub) x0[sub] = *(const u32x4*)(X0 + blk_elem_k(R0 + tt, d0 + 64 * sub + 8 * dd8, DM));
#pragma unroll
      for (int sub = 0; sub < 4; ++sub) { float z[8];
#pragma unroll
        for (int e = 0; e < 8; ++e) z[e] = bf2f(tile[(64 * sub + 8 * dd8 + e) * 72 + tt]);
        u32x4 w; w.x = pk2(z[0] * bflo(x0[sub].x), z[1] * bfhi(x0[sub].x)); w.y = pk2(z[2] * bflo(x0[sub].y), z[3] * bfhi(x0[sub].y)); w.z = pk2(z[4] * bflo(x0[sub].z), z[5] * bfhi(x0[sub].z)); w.w = pk2(z[6] * bflo(x0[sub].w), z[7] * bfhi(x0[sub].w));
        *(u32x4*)(YB + blk_elem_k(R0 + tt, d0 + 64 * sub + 8 * dd8, DM)) = w; } }
    __syncthreads();
}
DEVFN void phase_hy_post(const Params& p, char* smem) {
    for (int u = blockIdx.x; u < 2048 + 128; u += gridDim.x) {
        if (u < 2048) { const int dt = u & 3, tt = (u >> 2) & 63, b = u >> 8; hy_post_unit(p, smem, b * SEQ + tt * 64, tt * 64, SEQ, dt * 256, (const bf16_t*)(p.BIG + HY_YTL) + (size_t)b * DM * SEQ, (const bf16_t*)(p.BIG + HY_VXTL) + (size_t)b * DM * SEQ); }
        else { const int v = u - 2048, dt = v & 3, tt = (v >> 2) & 3, b = v >> 4; hy_post_unit(p, smem, TL + b * CTXL + tt * 64, tt * 64, CTXL, dt * 256, (const bf16_t*)(p.BIG + HY_YTC) + (size_t)b * DM * CTXL, (const bf16_t*)(p.BIG + HY_VXTC) + (size_t)b * DM * CTXL); }
    }
}

DEVFN void gm_sp_unit(const Params& p, char* smem, int ck, int g) {
    constexpr int PROW = 272;
    LAS unsigned char* lds = (LAS unsigned char*)smem;
    LAS float* mu = (LAS float*)(lds + 192 * PROW);
    LAS float* rs = mu + 128;
    const bf16_t* ZU = (const bf16_t*)(p.BIG + GM_Z); const bf16_t* VT = (const bf16_t*)(p.BIG + GM_VT); bf16_t* UV = (bf16_t*)(p.BIG + GM_UV);
    const int tid = TIDX, lane = tid & 63, w = __builtin_amdgcn_readfirstlane(tid >> 6), fr = lane & 15, fq = lane >> 4;
    { const bf16_t* src = VT + ((size_t)ck * 3072 + g * 192) * 128;
#pragma unroll
      for (int i = 0; i < 6; ++i) { const int idx = tid + NTHREADS * i, c = ((idx >> 8) << 4) + (idx & 15), ch = (idx >> 4) & 15, w5 = c & 31, slot = (c & ~31) + 16 * ((w5 >> 2) & 1) + 4 * (w5 >> 3) + (w5 & 3);
          *(LAS u32x4*)(lds + slot * PROW + ch * 16) = *(const u32x4*)(src + blk_elem_k(c, ch * 8, 128)); }
      if (tid < 128) { const f32x4* sp = (const f32x4*)(p.STAT + (size_t)(ck * 128 + tid) * 48); float sx = 0.f, sy = 0.f;
#pragma unroll
          for (int k = 0; k < 12; ++k) { const f32x4 v = sp[k]; sx += v[0]; sy += v[1]; sx += v[2]; sy += v[3]; }
          const float mean = sx * (1.0f / 3072.0f), var = fmaxf(sy * (1.0f / 3072.0f) - mean * mean, 0.f);
          mu[tid] = mean; rs[tid] = rsqrtf(var + 1e-6f); } }
    __syncthreads();
    bf16x8 af[4], mf[4];
    { const bf16_t* ap = p.GMWS + (size_t)(g * 128 + 16 * w + fr) * 128 + 8 * fq;
#pragma unroll
      for (int kk = 0; kk < 4; ++kk) { const u32x4 a = *(const u32x4*)(ap + 32 * kk); const int q0 = 32 * kk + 8 * fq;
          const f32x4 r0 = *(const LAS f32x4*)(rs + q0), r1 = *(const LAS f32x4*)(rs + q0 + 4), m0 = *(const LAS f32x4*)(mu + q0), m1 = *(const LAS f32x4*)(mu + q0 + 4);
          union { bf16x8 v; u32x4 u; } x, y;
          x.u = (u32x4){pk2(bflo(a.x) * r0[0], bfhi(a.x) * r0[1]), pk2(bflo(a.y) * r0[2], bfhi(a.y) * r0[3]), pk2(bflo(a.z) * r1[0], bfhi(a.z) * r1[1]), pk2(bflo(a.w) * r1[2], bfhi(a.w) * r1[3])};
          y.u = pack8(m0, m1); af[kk] = x.v; mf[kk] = y.v; } }
    f32x4 acc[12], acc1 = (f32x4){0.f, 0.f, 0.f, 0.f};
#pragma unroll
    for (int nt = 0; nt < 12; ++nt) acc[nt] = (f32x4){0.f, 0.f, 0.f, 0.f};
#pragma unroll
    for (int kk = 0; kk < 4; ++kk) {
        acc1 = __builtin_amdgcn_mfma_f32_16x16x32_bf16(mf[kk], af[kk], acc1, 0, 0, 0);
#pragma unroll
        for (int nt = 0; nt < 12; ++nt) { const bf16x8 bf = *(const LAS bf16x8*)(lds + (16 * nt + fr) * PROW + (32 * kk + 8 * fq) * 2); acc[nt] = __builtin_amdgcn_mfma_f32_16x16x32_bf16(bf, af[kk], acc[nt], 0, 0, 0); } }
    const int prow = 16 * w + fr, row = ck * 128 + prow; const float bsv = p.gm_b_s[g * 128 + prow], s0 = p.GMS0[g * 128 + prow], s1 = acc1[0];
#pragma unroll
    for (int np = 0; np < 6; ++np) { const int col = g * 192 + 32 * np + 8 * fq; const u32x4 uu = *(const u32x4*)(ZU + blk_elem_k(row, col, 3072));
        const f32x4 lg0 = *(const f32x4*)(p.gm_ln_g + col), lg1 = *(const f32x4*)(p.gm_ln_g + col + 4), lb0 = *(const f32x4*)(p.gm_ln_b + col), lb1 = *(const f32x4*)(p.gm_ln_b + col + 4);
        const f32x4 o0 = (lg0 * (acc[2 * np] - s1) + lb0 * s0 + bsv) * (f32x4){bflo(uu.x), bfhi(uu.x), bflo(uu.y), bfhi(uu.y)};
        const f32x4 o1 = (lg1 * (acc[2 * np + 1] - s1) + lb1 * s0 + bsv) * (f32x4){bflo(uu.z), bfhi(uu.z), bflo(uu.w), bfhi(uu.w)};
        *(u32x4*)(UV + blk_elem_k(row, col, 3072)) = pack8(o0, o1); }
    __syncthreads();
}

DEVFN void phase_n2_route(const Params& p, char* smem, int layer, int ntok, int dry) {
    constexpr int WROW = 2064, WLO = 32 * WROW, GSOFF = 2 * WLO, MISC = GSOFF + 16384;
    LAS unsigned char* lds = (LAS unsigned char*)smem;
    LAS float* GS = (LAS float*)(lds + GSOFF);
    int* lcnt = (int*)(smem + MISC);
    int* gbase = lcnt + 32;
    int* ent = gbase + 32;
    const int tid = TIDX, lane = tid & 63, wave = __builtin_amdgcn_readfirstlane(tid >> 6), t = lane & 15, g = lane >> 4;
    const int CT = ntok / 256, PW = CT >> 3;
    if (layer >= 1) conv_drain(p, smem, layer);
    const float* rw = p.moe_router_w + (size_t)layer * 1024 * 32;
    for (int idx = tid; idx < 8192; idx += NTHREADS) { const f32x4 v = *(const f32x4*)(rw + 4 * idx); const int c = idx >> 3, e0 = (idx & 7) * 4;
#pragma unroll
        for (int jj = 0; jj < 4; ++jj) { const unsigned hi = pk2(v[jj], 0.f) & 0xffffu; const float lo = v[jj] - __uint_as_float(hi << 16);
            *(LAS bf16_t*)(lds + (e0 + jj) * WROW + c * 2) = (bf16_t)hi; *(LAS bf16_t*)(lds + WLO + (e0 + jj) * WROW + c * 2) = (bf16_t)(pk2(lo, 0.f) & 0xffffu); } }
    const float rb0 = p.moe_router_b[layer * 32 + t], rb1 = p.moe_router_b[layer * 32 + 16 + t];
    const float* g2n = p.norm2_g + layer * 1024;
    for (int chunk = blockIdx.x; chunk < 256; chunk += gridDim.x) {
        const int tokc0 = chunk * CT, tokc1 = tokc0 + CT - 1, mrA = tokc0 < TL ? (tokc0 >> 12) : 8, mrB = tokc1 < TL ? (tokc1 >> 12) : 8;
        __syncthreads();
        if (tid < 32) lcnt[tid] = 0;
        for (int idx = tid; idx < 2048; idx += NTHREADS) { const int sl = idx >> 10, c = idx & 1023; const float* mod = p.MOD + ((size_t)layer * 9 + (sl ? mrB : mrA)) * 6144;
            GS[sl * 2048 + c] = g2n[c] * (mod[4 * 1024 + c] + 1.0f); GS[sl * 2048 + 1024 + c] = mod[3 * 1024 + c]; }
        __syncthreads();
        {
            const bool hasB = PW > 16;
            const int tl0 = wave * PW;
            const int tok = tokc0 + tl0 + t, mr = tok < TL ? (tok >> 12) : 8;
            const int tokB = tokc0 + tl0 + (hasB ? 16 : 15), mrB = tokB < TL ? (tokB >> 12) : 8;
            const LAS float* Gt = GS + (mr == mrA ? 0 : 2048);
            const LAS float* GtB = GS + (mrB == mrA ? 0 : 2048);
            const bool sameG = __all(mr == mrB) != 0;
            const bf16_t* xrow = p.X + (size_t)tok * DM + 8 * g;
            const bf16_t* xrowB = p.X + (size_t)tokB * DM + 8 * g;
            float ss = 0.f, ssB = 0.f;
            { u32x4 xs[32];
              u32x4 xb0 = (u32x4){0u, 0u, 0u, 0u}, xb1 = xb0;
#pragma unroll
              for (int s = 0; s < 32; ++s) xs[s] = *(const u32x4*)(xrow + 32 * s);
              if (hasB) { xb0 = *(const u32x4*)(xrowB + 32 * t); xb1 = *(const u32x4*)(xrowB + 32 * (t + 16)); }
              asm volatile("" ::: "memory");
#pragma unroll
              for (int s = 0; s < 32; ++s) { const u32x4 xv = xs[s];
                const float a0 = bflo(xv.x), a1 = bfhi(xv.x), a2 = bflo(xv.y), a3 = bfhi(xv.y), a4 = bflo(xv.z), a5 = bfhi(xv.z), a6 = bflo(xv.w), a7 = bfhi(xv.w);
                ss += ((a0 * a0 + a1 * a1) + (a2 * a2 + a3 * a3)) + ((a4 * a4 + a5 * a5) + (a6 * a6 + a7 * a7)); }
#pragma unroll
              for (int hh = 0; hh < 2; ++hh) { const u32x4 xv = hh ? xb1 : xb0;
                const float a0 = bflo(xv.x), a1 = bfhi(xv.x), a2 = bflo(xv.y), a3 = bfhi(xv.y), a4 = bflo(xv.z), a5 = bfhi(xv.z), a6 = bflo(xv.w), a7 = bfhi(xv.w);
                ssB += ((a0 * a0 + a1 * a1) + (a2 * a2 + a3 * a3)) + ((a4 * a4 + a5 * a5) + (a6 * a6 + a7 * a7)); } }
            ss += __shfl_xor(ss, 16); ss += __shfl_xor(ss, 32);
            ssB = wave_sum(ssB);
            const float r = rsqrtf(ss * (1.0f / DM) + 1e-6f), rB = rsqrtf(ssB * (1.0f / DM) + 1e-6f);
            f32x4 acc0 = (f32x4){0.f, 0.f, 0.f, 0.f}, acc1 = acc0, accB0 = acc0, accB1 = acc0;
            bf16_t* hrow = p.HX + (size_t)tok * DM + 8 * g;
            bf16_t* hrowB = p.HX + (size_t)tokB * DM + 8 * g;
#pragma unroll 4
            for (int s = 0; s < 32; ++s) {
                const int c0 = 32 * s + 8 * g; const u32x4 xv = *(const u32x4*)(xrow + 32 * s);
                u32x4 xvB = (u32x4){0u, 0u, 0u, 0u}; if (hasB) xvB = *(const u32x4*)(xrowB + 32 * s);
                const LAS unsigned char* wp = lds + t * WROW + c0 * 2;
                const bf16x8 wh0 = *(const LAS bf16x8*)(wp), wh1 = *(const LAS bf16x8*)(wp + 16 * WROW), wl0 = *(const LAS bf16x8*)(wp + WLO), wl1 = *(const LAS bf16x8*)(wp + WLO + 16 * WROW);
                const f32x4 G0 = *(const LAS f32x4*)(Gt + c0), G1 = *(const LAS f32x4*)(Gt + c0 + 4), S0 = *(const LAS f32x4*)(Gt + 1024 + c0), S1 = *(const LAS f32x4*)(Gt + 1024 + c0 + 4);
                { const f32x4 x0 = (f32x4){bflo(xv.x), bfhi(xv.x), bflo(xv.y), bfhi(xv.y)}, x1 = (f32x4){bflo(xv.z), bfhi(xv.z), bflo(xv.w), bfhi(xv.w)};
                  const f32x4 h0 = (x0 * r) * G0 + S0, h1 = (x1 * r) * G1 + S1;
                  union { bf16x8 v; u32x4 u; } hi, lo;
                  hi.u = pack8(h0, h1);
                  if (!dry || hi.u.x == 0x12345u) *(u32x4*)(hrow + 32 * s) = hi.u;
                  const f32x4 l0 = h0 - (f32x4){bflo(hi.u.x), bfhi(hi.u.x), bflo(hi.u.y), bfhi(hi.u.y)}, l1 = h1 - (f32x4){bflo(hi.u.z), bfhi(hi.u.z), bflo(hi.u.w), bfhi(hi.u.w)};
                  lo.u = pack8(l0, l1);
                  acc0 = __builtin_amdgcn_mfma_f32_16x16x32_bf16(hi.v, wh0, acc0, 0, 0, 0); acc0 = __builtin_amdgcn_mfma_f32_16x16x32_bf16(lo.v, wh0, acc0, 0, 0, 0); acc0 = __builtin_amdgcn_mfma_f32_16x16x32_bf16(hi.v, wl0, acc0, 0, 0, 0);
                  acc1 = __builtin_amdgcn_mfma_f32_16x16x32_bf16(hi.v, wh1, acc1, 0, 0, 0); acc1 = __builtin_amdgcn_mfma_f32_16x16x32_bf16(lo.v, wh1, acc1, 0, 0, 0); acc1 = __builtin_amdgcn_mfma_f32_16x16x32_bf16(hi.v, wl1, acc1, 0, 0, 0); }
                if (hasB) {
                  f32x4 G0b = G0, G1b = G1, S0b = S0, S1b = S1;
                  if (!sameG) { G0b = *(const LAS f32x4*)(GtB + c0); G1b = *(const LAS f32x4*)(GtB + c0 + 4); S0b = *(const LAS f32x4*)(GtB + 1024 + c0); S1b = *(const LAS f32x4*)(GtB + 1024 + c0 + 4); }
                  const f32x4 x0 = (f32x4){bflo(xvB.x), bfhi(xvB.x), bflo(xvB.y), bfhi(xvB.y)}, x1 = (f32x4){bflo(xvB.z), bfhi(xvB.z), bflo(xvB.w), bfhi(xvB.w)};
                  const f32x4 h0 = (x0 * rB) * G0b + S0b, h1 = (x1 * rB) * G1b + S1b;
                  union { bf16x8 v; u32x4 u; } hi, lo;
                  hi.u = pack8(h0, h1);
                  if (t == 0 && (!dry || hi.u.x == 0x12345u)) *(u32x4*)(hrowB + 32 * s) = hi.u;
                  const f32x4 l0 = h0 - (f32x4){bflo(hi.u.x), bfhi(hi.u.x), bflo(hi.u.y), bfhi(hi.u.y)}, l1 = h1 - (f32x4){bflo(hi.u.z), bfhi(hi.u.z), bflo(hi.u.w), bfhi(hi.u.w)};
                  lo.u = pack8(l0, l1);
                  accB0 = __builtin_amdgcn_mfma_f32_16x16x32_bf16(hi.v, wh0, accB0, 0, 0, 0); accB0 = __builtin_amdgcn_mfma_f32_16x16x32_bf16(lo.v, wh0, accB0, 0, 0, 0); accB0 = __builtin_amdgcn_mfma_f32_16x16x32_bf16(hi.v, wl0, accB0, 0, 0, 0);
                  accB1 = __builtin_amdgcn_mfma_f32_16x16x32_bf16(hi.v, wh1, accB1, 0, 0, 0); accB1 = __builtin_amdgcn_mfma_f32_16x16x32_bf16(lo.v, wh1, accB1, 0, 0, 0); accB1 = __builtin_amdgcn_mfma_f32_16x16x32_bf16(hi.v, wl1, accB1, 0, 0, 0); }
            }
#pragma unroll 1
            for (int pass = 0; pass < (hasB ? 2 : 1); ++pass) {
                const int tlb = pass ? tl0 + 16 : tl0, ntile = pass ? 1 : 16;
                float v0[4], v1[4]; float tv[4][4]; int te[4][4];
#pragma unroll
                for (int j = 0; j < 4; ++j) { v0[j] = (pass ? accB0[j] : acc0[j]) + rb0; v1[j] = (pass ? accB1[j] : acc1[j]) + rb1; }
#pragma unroll
                for (int k = 0; k < 4; ++k)
#pragma unroll
                    for (int j = 0; j < 4; ++j) { float m = fmaxf(v0[j], v1[j]);
                        m = fmaxf(m, __shfl_xor(m, 1)); m = fmaxf(m, __shfl_xor(m, 2)); m = fmaxf(m, __shfl_xor(m, 4)); m = fmaxf(m, __shfl_xor(m, 8));
                        int cand = (v0[j] == m) ? t : ((v1[j] == m) ? 16 + t : 99);
                        cand = min(cand, __shfl_xor(cand, 1)); cand = min(cand, __shfl_xor(cand, 2)); cand = min(cand, __shfl_xor(cand, 4)); cand = min(cand, __shfl_xor(cand, 8));
                        cand &= 31; tv[j][k] = m; te[j][k] = cand; if (cand == t) v0[j] = -INFINITY; if (cand == 16 + t) v1[j] = -INFINITY; }
                if (t == 0) {
#pragma unroll
                    for (int j = 0; j < 4; ++j) { const int tt = 4 * g + j;
                        if (tt < ntile) { const float e1 = __expf(tv[j][1] - tv[j][0]), e2 = __expf(tv[j][2] - tv[j][0]), e3 = __expf(tv[j][3] - tv[j][0]), rinv = 1.0f / (1.0f + e1 + e2 + e3);
                            const float gt[4] = {rinv, e1 * rinv, e2 * rinv, e3 * rinv}; const int tl = tlb + tt;
#pragma unroll
                            for (int k = 0; k < 4; ++k) { const int lp = atomicAdd(&lcnt[te[j][k]], 1); ent[(tl * 4 + k) * 3] = te[j][k]; ent[(tl * 4 + k) * 3 + 1] = lp; ent[(tl * 4 + k) * 3 + 2] = __float_as_int(gt[k]); } } }
                }
            }
        }
        __syncthreads();
        if (tid < 32) gbase[tid] = dry ? 0 : __hip_atomic_fetch_add(p.cnt + layer * 32 + tid, lcnt[tid], __ATOMIC_RELAXED, __HIP_MEMORY_SCOPE_AGENT);
        __syncthreads();
        for (int idx = tid; idx < CT * 4; idx += NTHREADS) { const int e = ent[idx * 3], pos = gbase[e] + ent[idx * 3 + 1]; const int tok = chunk * CT + (idx >> 2);
            if (!dry || pos == 0x7fffffff) { p.toklist[(size_t)e * TT + pos] = tok; p.gatelist[(size_t)e * TT + pos] = __int_as_float(ent[idx * 3 + 2]); p.assign[(size_t)tok * 4 + (idx & 3)] = (e << 20) | pos; } }
    }
    __syncthreads();
}
DEVFN int moe_tables(const Params& p, char* smem, int layer) {
    int* tstart = (int*)(smem + SMEM_GEMM); int* ecnt = tstart + 64;
    __syncthreads();
    if (TIDX < 64) { const int lane = TIDX; const int c = lane < 32 ? __hip_atomic_load(p.cnt + layer * 32 + lane, __ATOMIC_RELAXED, __HIP_MEMORY_SCOPE_AGENT) : 0; const int nt = (c + 255) >> 8; int inc = nt;
#pragma unroll
        for (int o = 1; o < 32; o <<= 1) { const int t = __shfl_up(inc, o); if ((lane & 31) >= o) inc += t; }
        if (lane < 32) { tstart[lane + 1] = inc; ecnt[lane] = c; if (lane == 0) tstart[0] = 0; } }
    __syncthreads();
    return tstart[32];
}
template <int NP> DEVFN bool moe_unit(int ui, int R, int& rt, int& pn) {
    constexpr int RPX = 32 / NP; const int b = blockIdx.x, x = b & 7, j = (b >> 3) & 31, g32 = b >> 8;
    const int rounds_per = (gridDim.x + 255) >> 8;
    rt = ((ui * rounds_per + g32) * 8 + x) * RPX + j / NP; pn = j % NP; return rt < R;
}
struct ProvMoe1 {
    const Params* p; const int* tstart; const int* ecnt; int layer, R, dry;
    DEVFN bool next(int ui, const char*& A, const char*& B, unsigned (&va)[2][2], EpiSwiglu& epi) const {
        int rt, pn; if (!moe_unit<8>(ui, R, rt, pn)) return false;
        int e = 0;
#pragma unroll 1
        for (int k = 16; k >= 1; k >>= 1) if (tstart[e + k] <= rt) e += k;
        const int rb = rt - tstart[e], cnt = ecnt[e];
#pragma unroll
        for (int i = 0; i < 2; ++i) { int r, c; stage_rc(TIDX * 16 + i * 8192, r, c);
#pragma unroll
            for (int hh = 0; hh < 2; ++hh) { const int pos = min(rb * 256 + hh * 128 + r, cnt - 1); const int tok = p->toklist[(size_t)e * TT + pos]; va[hh][i] = ((unsigned)tok * DM + c) * 2u; } }
        A = (const char*)p->HX; B = (const char*)(p->MOEGU + ((size_t)layer * 32 + e) * 2048 * 1024 + (size_t)pn * 256 * DM);
        epi = EpiSwiglu{p->ACT, rt * 256, pn * 128, p->moe_b_gu + ((size_t)layer * 32 + e) * 2048, dry};
        return true;
    }
};
struct ProvMoe2 {
    const Params* p; const int* tstart; const int* ecnt; int layer, R, dry;
    DEVFN bool next(int ui, const char*& A, const char*& B, unsigned (&va)[2][2], EpiMoeDn& epi) const {
        int rt, pn; if (!moe_unit<4>(ui, R, rt, pn)) return false;
        int e = 0;
#pragma unroll 1
        for (int k = 16; k >= 1; k >>= 1) if (tstart[e + k] <= rt) e += k;
        const int rb = rt - tstart[e], cnt = ecnt[e];
        A = (const char*)(p->ACT + (size_t)rt * 256 * DM); B = (const char*)(p->MOEDN + ((size_t)layer * 32 + e) * 1024 * 1024 + (size_t)pn * 256 * DM);
        epi = EpiMoeDn{p->OUTS, rt * 256, pn * 256, p->moe_b_dn + ((size_t)layer * 32 + e) * 1024, p->gatelist + (size_t)e * TT, cnt, rb, dry};
        return true;
    }
};
DEVFN void phase_moe1(const Params& p, char* smem, int layer, int dry) {
    const int R = moe_tables(p, smem, layer); const int* tstart = (const int*)(smem + SMEM_GEMM); const int* ecnt = tstart + 64;
    int rt, pn, ui = 0;
    for (; moe_unit<8>(ui, R, rt, pn); ++ui) {
        int e = 0;
#pragma unroll 1
        for (int k = 16; k >= 1; k >>= 1) if (tstart[e + k] <= rt) e += k;
        const int rb = rt - tstart[e], cnt = ecnt[e];
        unsigned va[2][2], vb[2];
#pragma unroll
        for (int i = 0; i < 2; ++i) { int r, c; stage_rc(TIDX * 16 + i * 8192, r, c);
#pragma unroll
            for (int hh = 0; hh < 2; ++hh) { const int pos = min(rb * 256 + hh * 128 + r, cnt - 1); const int tok = p.toklist[(size_t)e * TT + pos]; va[hh][i] = ((unsigned)tok * DM + c) * 2u; } }
        blk_voff(vb);
        const char* W = (const char*)(p.MOEGU + ((size_t)layer * 32 + e) * 2048 * 1024 + (size_t)pn * 256 * DM);
        EpiSwiglu epi{p.ACT, rt * 256, pn * 128, p.moe_b_gu + ((size_t)layer * 32 + e) * 2048, dry};
        gemm_tile<true, EpiSwiglu, BK * 2, 2048>(smem, (const char*)p.HX, (const char*)p.HX, va, W, W + (size_t)HALF * DM * 2, vb, DM / BK, epi);
    }
    if (ui < ((R + 31) >> 5) * ((gridDim.x + 255) >> 8)) conv_fill(p, smem, layer + 1, FILL_MOE);
}
DEVFN void phase_moe2(const Params& p, char* smem, int layer, int dry) {
    const int R = moe_tables(p, smem, layer); const int* tstart = (const int*)(smem + SMEM_GEMM); const int* ecnt = tstart + 64;
    int rt, pn, ui = 0;
    for (; moe_unit<4>(ui, R, rt, pn); ++ui) {
        int e = 0;
#pragma unroll 1
        for (int k = 16; k >= 1; k >>= 1) if (tstart[e + k] <= rt) e += k;
        const int rb = rt - tstart[e], cnt = ecnt[e];
        unsigned va[2][2], vb[2], vt[2]; blk_voff(vt); blk_voff(vb); va[0][0] = va[1][0] = vt[0]; va[0][1] = va[1][1] = vt[1];
        const char* A = (const char*)(p.ACT + (size_t)rt * 256 * DM); const char* W = (const char*)(p.MOEDN + ((size_t)layer * 32 + e) * 1024 * 1024 + (size_t)pn * 256 * DM);
        EpiMoeDn epi{p.OUTS, rt * 256, pn * 256, p.moe_b_dn + ((size_t)layer * 32 + e) * 1024, p.gatelist + (size_t)e * TT, cnt, rb, dry};
        gemm_tile<true, EpiMoeDn, 2048, 2048>(smem, A, A + (size_t)HALF * DM * 2, va, W, W + (size_t)HALF * DM * 2, vb, DM / BK, epi);
    }
    if (ui < ((R + 63) >> 6) * ((gridDim.x + 255) >> 8)) conv_fill(p, smem, layer + 1, FILL_MOE);
}
DEVFN void phase_combine(const Params& p, int layer, bool last, int dry) {
    const int lane = TIDX & 63, gw = blockIdx.x * 8 + (TIDX >> 6), NW = gridDim.x * 8, ntok = last ? TL : TT;
    int tst;
    { const int c = lane < 32 ? __hip_atomic_load(p.cnt + layer * 32 + lane, __ATOMIC_RELAXED, __HIP_MEMORY_SCOPE_AGENT) : 0; const int nt = (c + 255) >> 8; int inc = nt;
#pragma unroll
        for (int o = 1; o < 32; o <<= 1) { const int t = __shfl_up(inc, o); if ((lane & 31) >= o) inc += t; }
        tst = inc - nt; }
    const int per = (ntok + NW - 1) / NW, tok0 = gw * per, cnt = min(per, ntok - tok0);
    if (cnt <= 0) return;
    int myslot[4];
    { int a[4];
#pragma unroll
      for (int k = 0; k < 4; ++k) a[k] = lane < cnt ? p.assign[(size_t)(tok0 + lane) * 4 + k] : 0;
#pragma unroll
      for (int k = 0; k < 4; ++k) myslot[k] = 256 * __shfl(tst, (a[k] >> 20) & 31) + (a[k] & 0xfffff); }
    int cur_mr = -1; f32x4 G2[4], GN[4], SH[4];
#pragma unroll
    for (int i = 0; i < 4; ++i) { G2[i] = (f32x4){0.f, 0.f, 0.f, 0.f}; GN[i] = G2[i]; SH[i] = G2[i]; }
#pragma unroll 1
    for (int ti = 0; ti < cnt; ti += 2) {
        const bool hasB = ti + 1 < cnt; const int tokA = tok0 + ti, tokB = hasB ? tokA + 1 : tokA;
        int sA[4], sB[4];
#pragma unroll
        for (int k = 0; k < 4; ++k) { sA[k] = __shfl(myslot[k], ti); sB[k] = __shfl(myslot[k], hasB ? ti + 1 : ti); }
        u32x2 xa[4], xb[4]; u32x2 oa[4][4], ob[4][4];
#pragma unroll
        for (int i = 0; i < 4; ++i) { const int c = 4 * lane + 256 * i; xa[i] = *(const u32x2*)(p.X + (size_t)tokA * DM + c);
#pragma unroll
            for (int k = 0; k < 4; ++k) oa[i][k] = *(const u32x2*)(p.OUTS + (size_t)sA[k] * DM + c); }
#pragma unroll
        for (int i = 0; i < 4; ++i) { const int c = 4 * lane + 256 * i; xb[i] = *(const u32x2*)(p.X + (size_t)tokB * DM + c);
#pragma unroll
            for (int k = 0; k < 4; ++k) ob[i][k] = *(const u32x2*)(p.OUTS + (size_t)sB[k] * DM + c); }
#pragma unroll
        for (int half = 0; half < 2; ++half) {
            if (half == 1 && !hasB) break;
            const int tok = half ? tokB : tokA, mr = tok < TL ? (tok >> 12) : 8;
            if (mr != cur_mr) { cur_mr = mr; const float* g2 = p.MOD + ((size_t)layer * 9 + mr) * 6144 + 5 * 1024;
                const float* gn = last ? p.final_g : p.norm1_g + (layer + 1) * 1024; const float* mod = p.MOD + ((size_t)(last ? layer : layer + 1) * 9 + mr) * 6144;
#pragma unroll
                for (int i = 0; i < 4; ++i) { const int c = 4 * lane + 256 * i; G2[i] = *(const f32x4*)(g2 + c);
                    if (last) { GN[i] = *(const f32x4*)(gn + c); } else { GN[i] = *(const f32x4*)(gn + c) * (*(const f32x4*)(mod + 1024 + c) + 1.0f); SH[i] = *(const f32x4*)(mod + c); } } }
            f32x4 v[4]; float ss = 0.f;
#pragma unroll
            for (int i = 0; i < 4; ++i) { f32x4 y = (f32x4){0.f, 0.f, 0.f, 0.f};
#pragma unroll
                for (int k = 0; k < 4; ++k) { const u32x2 w = half ? ob[i][k] : oa[i][k]; y += (f32x4){bflo(w.x), bfhi(w.x), bflo(w.y), bfhi(w.y)}; }
                { const u32x2 xw = half ? xb[i] : xa[i]; v[i] = (f32x4){bflo(xw.x), bfhi(xw.x), bflo(xw.y), bfhi(xw.y)} + G2[i] * y; } ss += (v[i][0] * v[i][0] + v[i][1] * v[i][1]) + (v[i][2] * v[i][2] + v[i][3] * v[i][3]); }
            const float r = rsqrtf(wave_sum(ss) * (1.0f / DM) + 1e-6f);
            if (!last) {
#pragma unroll
                for (int i = 0; i < 4; ++i) { const int c = 4 * lane + 256 * i; if (dry && v[i][0] != 1.2345678e-33f) continue; { u32x2 xw; xw.x = pk2(v[i][0], v[i][1]); xw.y = pk2(v[i][2], v[i][3]); *(u32x2*)(p.X + (size_t)tok * DM + c) = xw; }
                    const f32x4 h = (v[i] * r) * GN[i] + SH[i]; u32x2 w; w.x = pk2(h[0], h[1]); w.y = pk2(h[2], h[3]); *(u32x2*)(p.HX + (size_t)tok * DM + c) = w; }
            } else {
#pragma unroll
                for (int i = 0; i < 4; ++i) { const int c = 4 * lane + 256 * i; if (dry && v[i][0] != 1.2345678e-33f) continue; *(f32x4*)(p.out + (size_t)tok * DM + c) = (v[i] * r) * GN[i]; }
            }
        }
    }
}

DEVFN LAS float* epi_slot(char* smem, int it) { return (LAS float*)(smem + SMEM_GEMM + 1024 + (it & 1) * 4096); }
template <bool TRANS, class EPI, bool WBLK = true, bool ABLK = false>
DEVFN void dense_tile(char* smem, const bf16_t* A, const bf16_t* Bt, int K, int pm, int pn, const EPI& epi) {
    unsigned va[2][2], vb[2], vt[2]; if (ABLK) blk_voff_k(vt, K); else lin_voff(vt, K); if (WBLK) blk_voff_k(vb, K); else lin_voff_b(vb, K); va[0][0] = va[1][0] = vt[0]; va[0][1] = va[1][1] = vt[1];
    const char* a = (const char*)(A + (size_t)pm * 256 * K); const char* b = (const char*)(Bt + (size_t)pn * 256 * K); const size_t hs = (size_t)HALF * K * 2;
    if (WBLK && ABLK) gemm_tile<TRANS, EPI, 2048, 2048>(smem, a, a + hs, va, b, b + hs, vb, K / BK, epi);
    else if (WBLK) gemm_tile<TRANS, EPI, BK * 2, 2048>(smem, a, a + hs, va, b, b + hs, vb, K / BK, epi);
    else gemm_tile<TRANS>(smem, a, a + hs, va, b, b + hs, vb, K / BK, epi);
}
DEVFN void phase_qkv(const Params& p, char* smem, int j) {
    const bf16_t* W = p.WQKV + (size_t)j * 3072 * 1024;
    bf16_t* Q = (bf16_t*)(p.BIG + NA_Q); bf16_t* Kb = (bf16_t*)(p.BIG + NA_K); bf16_t* VtL = (bf16_t*)(p.BIG + NA_VTL); bf16_t* VtC = (bf16_t*)(p.BIG + NA_VTC);
    int pm, pn;
    for (int it = 0; tile_order(it, TT / 256, 12, pm, pn); ++it) {
        if (pn < 8) { EpiQK epi{pn < 4 ? Q : Kb, pm * 256, (pn & 3) * 256, pn < 4 ? 0.125f * 1.44269504f : 1.0f, pn >= 4}; dense_tile<true>(smem, p.HX, W, DM, pm, pn, epi); }
        else { EpiVt epi{VtL, VtC, pm * 256, (pn - 8) * 256}; dense_tile<false>(smem, p.HX, W, DM, pm, pn, epi); }
    }
    { const int rem = ((TT / 256) * 12) % (int)gridDim.x; if (rem && (int)blockIdx.x >= rem) conv_fill(p, smem, j ? 3 : 1, FILL_IN); }
}
DEVFN void phase_in_bf16(const Params& p, char* smem, const bf16_t* W, int N, const float* bias, bf16_t* dst, int gelu) {
    int pm, pn;
    for (int it = 0; tile_order(it, TT / 256, N / 256, pm, pn); ++it) { EpiBf16 epi{dst, N, pm * 256, pn * 256, bias, gelu, epi_slot(smem, it), 1}; epi.stage(); dense_tile<true>(smem, p.HX, W, DM, pm, pn, epi); }
    { const int rem = ((TT / 256) * (N / 256)) % (int)gridDim.x; if (rem && (int)blockIdx.x >= rem) conv_fill(p, smem, 1, FILL_IN); }
}
DEVFN void phase_gm_in(const Params& p, char* smem) {
    bf16_t* ZU = (bf16_t*)(p.BIG + GM_Z); bf16_t* VT = (bf16_t*)(p.BIG + GM_VT);
    constexpr int NU = (TT / 256) * 12;
    for (int it = 0;; ++it) {
        const long L = (long)it * gridDim.x + blockIdx.x; int pm, pn;
        if (L < NU) { tile_from_index(L, TT / 256, 12, pm, pn); EpiBf16 epi{ZU, 3072, pm * 256, pn * 256, p.gm_b_in, 1, epi_slot(smem, it), 1}; epi.stage(); dense_tile<true>(smem, p.HX, p.GMIN, DM, pm, pn, epi); }
        else if (tile_from_index(L - NU, 12, TT / 256, pm, pn)) { EpiVtG epi{VT, p.STAT, p.gm_b_in + 3072, pm * 256, pn * 256}; dense_tile<true, EpiVtG, false>(smem, p.GMIN + (size_t)3072 * DM, p.HX, DM, pm, pn, epi); }
        else break;
    }
    { const int rem = (NU * 2) % (int)gridDim.x; if (rem && (int)blockIdx.x >= rem) conv_fill(p, smem, 2, FILL_IN); }
}
DEVFN void phase_outproj(const Params& p, char* smem, const bf16_t* A, const bf16_t* W, int K, const float* bias, int layer, int nrows, int ablk) {
    int pm, pn;
    for (int rep = 0; rep < REP_OUT; ++rep) for (int it = 0; tile_order(it, nrows / 256, 4, pm, pn); ++it) { EpiResid epi{p.X, p.MOD + (size_t)layer * 9 * 6144 + 2 * 1024, bias, pm * 256, pn * 256, rep < REP_OUT - 1}; if (ablk) dense_tile<true, EpiResid, true, true>(smem, A, W, K, pm, pn, epi); else dense_tile<true>(smem, A, W, K, pm, pn, epi); }
    { const int rem = ((nrows / 256) * 4) % (int)gridDim.x; if (rem && (int)blockIdx.x >= rem) conv_fill(p, smem, layer < 1 ? 1 : layer, K == 3072 ? FILL_OUT3 : FILL_OUT); }
}

constexpr int NSEG = 32;
__global__ void __launch_bounds__(NTHREADS, 2) mega(Params p) {
    extern __shared__ __attribute__((aligned(16))) char smem[];
    volatile LAS unsigned* xbw = (volatile LAS unsigned*)(smem + SMEM_BYTES - 16);
    const bool single = (p.seg_hi - p.seg_lo) > 1;
    XcdBarrier bar; bar.bar = p.bar; bar.x = 0; bar.st = xbw;
    if (single) { if (TIDX == 0) { xbw[0] = 0u; xbw[1] = 0u; } __syncthreads(); bar = xcd_barrier_post(p.bar, xbw); }
    int seg = 0;
#if REP_BAR > 0
    if (single) for (int rep = 0; rep < REP_BAR; ++rep) xcd_barrier(bar);
#endif
#define SEG_BEGIN if (seg >= p.seg_lo && seg < p.seg_hi) {
#define SEG_END   if (single && seg + 1 < p.seg_hi) xcd_barrier(bar); } ++seg;

    SEG_BEGIN for (int rep = 0; rep < REP_P0; ++rep) phase_p0(p, smem); SEG_END
    SEG_BEGIN
        for (int rep = 0; rep < REP_P1A; ++rep) phase_n1_first(p);
        for (int rep = 0; rep < REP_P1B; ++rep) for (int u = blockIdx.x; u < 256 + 256; u += gridDim.x) { if (u < 256) hyb_unit<SEQ>(p, smem, u); else hyb_unit<CTXL>(p, smem, u - 256); }
    SEG_END
    for (int layer = 0; layer < 4; ++layer) {
        const int kind = layer % 3, j = layer / 3; const bool ctx_out = layer < 3;
        const bf16_t* oA; const bf16_t* oW; int oK; const float* oB;
        if (kind == 0) {
            SEG_BEGIN for (int rep = 0; rep < REP_QKV; ++rep) phase_qkv(p, smem, j); SEG_END
            SEG_BEGIN for (int rep = 0; rep < REP_ATTN; ++rep) phase_attn(p, smem, j, ctx_out); SEG_END
            oA = (const bf16_t*)(p.BIG + NA_O); oW = p.WO + (size_t)j * 1024 * 1024; oK = 1024; oB = nullptr;
        } else if (kind == 1) {
            SEG_BEGIN for (int rep = 0; rep < REP_DENSE; ++rep) phase_in_bf16(p, smem, p.HYIN, 3072, p.hy_b_in, (bf16_t*)(p.BIG + HY_U), 0); SEG_END
            SEG_BEGIN for (int rep = 0; rep < REP_MIXA; ++rep) phase_hy_gate(p, smem); SEG_END
            SEG_BEGIN
                for (int rep = 0; rep < REP_MIXB; ++rep) for (int u = blockIdx.x; u < 2048; u += gridDim.x) { if (u < 1024) hy_convmm_unit(p, smem, u); else hy_conv_unit<CTXL>(p, smem, u - 1024); }
            SEG_END
            SEG_BEGIN for (int rep = 0; rep < REP_MIXC; ++rep) phase_hy_post(p, smem); SEG_END
            oA = (const bf16_t*)(p.BIG + HY_YB); oW = p.HYOUT; oK = 1024; oB = p.hy_b_out;
        } else {
            SEG_BEGIN phase_gm_in(p, smem); SEG_END
            SEG_BEGIN for (int rep = 0; rep < REP_MIX2; ++rep) for (int u = blockIdx.x; u < 272 * 16; u += gridDim.x) gm_sp_unit(p, smem, u >> 4, u & 15); SEG_END
            oA = (const bf16_t*)(p.BIG + GM_UV); oW = p.GMOUT; oK = 3072; oB = p.gm_b_out;
        }
        const int nrows = ctx_out ? TT : TL;
        SEG_BEGIN phase_outproj(p, smem, oA, oW, oK, oB, layer, nrows, 1); SEG_END
        SEG_BEGIN for (int rep = 0; rep < REP_N2; ++rep) phase_n2_route(p, smem, layer, nrows, rep < REP_N2 - 1); SEG_END
        SEG_BEGIN for (int rep = 0; rep < REP_MOE; ++rep) phase_moe1(p, smem, layer, rep < REP_MOE - 1 ? REP_DRY : 0); SEG_END
        SEG_BEGIN for (int rep = 0; rep < REP_MOE; ++rep) phase_moe2(p, smem, layer, rep < REP_MOE - 1 ? REP_DRY : 0); SEG_END
        SEG_BEGIN for (int rep = 0; rep < REP_COMB; ++rep) phase_combine(p, layer, layer == 3, rep < REP_COMB - 1); SEG_END
    }
}

extern "C" void kernel_launch(void* const* d_in, const int* in_sizes, int n_in, void* d_out, int out_size, void* d_ws, size_t ws_size, hipStream_t stream) {
    static int grid = 0;
    if (grid == 0) {
        int dev = 0, cus = 0;
        hipGetDevice(&dev); hipDeviceGetAttribute(&cus, hipDeviceAttributeMultiprocessorCount, dev);
        if (hipFuncSetAttribute((const void*)mega, hipFuncAttributeMaxDynamicSharedMemorySize, SMEM_BYTES) != hipSuccess) { grid = -1; return; }
        int per_cu = 0; (void)hipOccupancyMaxActiveBlocksPerMultiprocessor(&per_cu, (const void*)mega, NTHREADS, SMEM_BYTES); (void)hipGetLastError();
        grid = cus > 0 ? cus : 256;
    }
    if (grid < 0) return;
    Params p{};
    const float* const* in = (const float* const*)d_in;
    p.x = in[0]; p.c = in[1]; p.ctx = in[2]; p.c_ctx = in[3]; p.ada_w = in[4]; p.ada_b = in[5]; p.norm1_g = in[6]; p.norm2_g = in[7]; p.final_g = in[8];
    p.na_w_qkv = in[9]; p.na_rpb = in[10]; p.na_w_o = in[11];
    p.hy_w_in = in[12]; p.hy_b_in = in[13]; p.hy_conv_w = in[14]; p.hy_conv_b = in[15]; p.hy_f_w1 = in[16]; p.hy_f_b1 = in[17]; p.hy_f_w2 = in[18]; p.hy_f_b2 = in[19];
    p.hy_f_w3 = in[20]; p.hy_f_b3 = in[21]; p.hy_f_freq = in[22]; p.hy_f_wout = in[23]; p.hy_skip = in[24]; p.hy_w_out = in[25]; p.hy_b_out = in[26];
    p.gm_w_in = in[27]; p.gm_b_in = in[28]; p.gm_ln_g = in[29]; p.gm_ln_b = in[30]; p.gm_w_s = in[31]; p.gm_b_s = in[32]; p.gm_w_out = in[33]; p.gm_b_out = in[34];
    p.moe_router_w = in[35]; p.moe_router_b = in[36]; p.moe_w_gu = in[37]; p.moe_b_gu = in[38]; p.moe_w_dn = in[39]; p.moe_b_dn = in[40];
    p.out = (float*)d_out;
    unsigned char* ws = (unsigned char*)d_ws; size_t off = 0;
    auto carve = [&](size_t bytes) { unsigned char* r = ws + off; off += (bytes + 255) & ~(size_t)255; return r; };
    p.bar = (unsigned*)carve(XCD_BAR_WORDS * 4);
    p.cnt = (int*)carve(144 * 4);
    p.X = (bf16_t*)carve((size_t)TT * DM * 2);
    p.HX = (bf16_t*)carve(SZ_TD);
    p.MOD = (float*)carve((size_t)4 * 9 * 6144 * 4);
    p.WQKV = (bf16_t*)carve((size_t)2 * 3072 * 1024 * 2);
    p.WO = (bf16_t*)carve((size_t)2 * 1024 * 1024 * 2);
    p.HYIN = (bf16_t*)carve((size_t)3072 * 1024 * 2);
    p.HYOUT = (bf16_t*)carve((size_t)1024 * 1024 * 2);
    p.GMIN = (bf16_t*)carve((size_t)6144 * 1024 * 2);
    p.GMOUT = (bf16_t*)carve((size_t)1024 * 3072 * 2);
    p.GMWS = (bf16_t*)carve((size_t)16 * 128 * 128 * 2);
    p.MOEGU = (bf16_t*)carve((size_t)128 * 2048 * 1024 * 2);
    p.MOEDN = (bf16_t*)carve((size_t)128 * 1024 * 1024 * 2);
    p.FA = (float*)carve((size_t)(SEQ + CTXL) * 64 * 4);
    p.RK4 = (bf16_t*)carve((size_t)1024 * 4 * 8192 * 2);
    p.KC = (float*)carve((size_t)1024 * 512 * 4);
    p.toklist = (int*)carve((size_t)32 * TT * 4);
    p.gatelist = (float*)carve((size_t)32 * TT * 4);
    p.assign = (int*)carve((size_t)TT * 4 * 4);
    p.ACT = (bf16_t*)carve((size_t)MOE_ROWS * DM * 2);
    p.OUTS = (bf16_t*)carve((size_t)MOE_ROWS * DM * 2);
    p.STAT = (float*)carve((size_t)TT * 48 * 4);
    p.GMS0 = (float*)carve((size_t)16 * 128 * 4);
    p.BIG = carve(BIG_BYTES);
    if (off > ws_size) return;
    hipMemsetAsync(p.bar, 0, XCD_BAR_WORDS * 4, stream);
#if MK_SINGLE
    p.seg_lo = 0; p.seg_hi = NSEG;
    hipLaunchKernelGGL(mega, dim3(grid), dim3(NTHREADS), SMEM_BYTES, stream, p);
#else
    for (int s = 0; s < NSEG; ++s) { p.seg_lo = s; p.seg_hi = s + 1; hipLaunchKernelGGL(mega, dim3(grid), dim3(NTHREADS), SMEM_BYTES, stream, p); }
#endif
}
```
